# Optimizing an MI355X kernel written in HIP

```python
import math
import jax, jax.numpy as jnp
from jax import lax
import numpy as np

D_MODEL = 1024
BATCH = 16
SEQ = 2048
DEPTH = 4

HEAD_DIM = 64
N_HEADS = D_MODEL // HEAD_DIM
N_KV_HEADS = 4
GROUP = N_HEADS // N_KV_HEADS
HQ = N_HEADS * HEAD_DIM
HKV = N_KV_HEADS * HEAD_DIM
N_A_LAYERS = DEPTH // 2
N_B_LAYERS = DEPTH - N_A_LAYERS
SWA_WINDOW = 128
Q_BLOCK = 128
N_BRANCH = 3
CMP_LEN = 32
CMP_STRIDE = 16
CMP_HIDDEN = 256
SEL_BLOCK = 64
SEL_TOP = 8
SEL_FORCE_LOCAL = 2
SEL_CHUNK = 32
NSA_WINDOW = 512
NUM_BUCKETS = 32
MAX_DISTANCE = 128
EPS = 1e-6
NEG = -1e30
FORCE_BONUS = 1e6
A_IN = 2 * HQ + 2 * HKV
B_IN = HQ + N_BRANCH * N_HEADS + N_BRANCH * HQ

kernel_name = "yoco_swa_sink_nsa_hybrid"


def rms_norm(x, g):
    xf = x.astype(jnp.float32)
    xf = xf * lax.rsqrt(jnp.mean(xf * xf, axis=-1, keepdims=True) + EPS)
    return (xf * g.astype(jnp.float32)).astype(x.dtype)


def t5_bucket(dist):
    d = jnp.maximum(dist, 0)
    max_exact = NUM_BUCKETS // 2
    large = max_exact + (jnp.log(jnp.maximum(d, 1).astype(jnp.float32) / max_exact)
                         / math.log(MAX_DISTANCE / max_exact)
                         * (NUM_BUCKETS - max_exact)).astype(jnp.int32)
    large = jnp.minimum(large, NUM_BUCKETS - 1)
    return jnp.where(d < max_exact, d, large)


def head_bias(table, dist):
    b = table[t5_bucket(dist)]
    b = jnp.moveaxis(b, -1, 0)
    return b.reshape(N_KV_HEADS, GROUP, *dist.shape)


def banded_attention(q, k, v, window, table, sink):
    B_, S = q.shape[0], q.shape[1]
    nb = S // Q_BLOCK
    n_prev = -(-(window - 1) // Q_BLOCK)
    pad = n_prev * Q_BLOCK
    span = pad + Q_BLOCK
    kp = jnp.pad(k, ((0, 0), (pad, 0), (0, 0), (0, 0)))
    vp = jnp.pad(v, ((0, 0), (pad, 0), (0, 0), (0, 0)))
    scale = HEAD_DIM ** -0.5

    def block(i):
        start = i * Q_BLOCK
        qb = lax.dynamic_slice_in_dim(q, start, Q_BLOCK, axis=1)
        kb = lax.dynamic_slice_in_dim(kp, start, span, axis=1)
        vb = lax.dynamic_slice_in_dim(vp, start, span, axis=1)
        qpos = start + jnp.arange(Q_BLOCK)
        kpos = start - pad + jnp.arange(span)
        dist = qpos[:, None] - kpos[None, :]
        mask = (dist >= 0) & (dist < window) & (kpos[None, :] >= 0)
        logits = jnp.einsum('bqhgd,bkhd->bhgqk', qb, kb,
                            preferred_element_type=jnp.float32) * scale
        logits = jnp.where(mask, logits + head_bias(table, dist), NEG)
        if sink is None:
            p = jax.nn.softmax(logits, axis=-1)
        else:
            s = sink.astype(jnp.float32)[None, :, :, None, None]
            m = jnp.maximum(jnp.max(logits, axis=-1, keepdims=True), s)
            e = jnp.exp(logits - m)
            p = e / (jnp.sum(e, axis=-1, keepdims=True) + jnp.exp(s - m))
        return jnp.einsum('bhgqk,bkhd->bqhgd', p.astype(v.dtype), vb)

    out = lax.map(block, jnp.arange(nb))
    return out.transpose(1, 0, 2, 3, 4, 5).reshape(q.shape)


def swa_layer(x, norm_g, w_in, q_gain, k_gain, sink, w_out, table):
    B_, S, _ = x.shape
    proj = rms_norm(x, norm_g) @ w_in
    q = rms_norm(proj[..., :HQ].reshape(B_, S, N_KV_HEADS, GROUP, HEAD_DIM), q_gain)
    k = rms_norm(proj[..., HQ:HQ + HKV].reshape(B_, S, N_KV_HEADS, HEAD_DIM), k_gain)
    v = proj[..., HQ + HKV:HQ + 2 * HKV].reshape(B_, S, N_KV_HEADS, HEAD_DIM)
    z = proj[..., HQ + 2 * HKV:]
    o = banded_attention(q, k, v, SWA_WINDOW, table, sink.reshape(N_KV_HEADS, GROUP))
    o = o.reshape(B_, S, HQ) * jax.nn.silu(z)
    return x + o @ w_out


def compress(t, pos_emb, w1, w2):
    B_, S = t.shape[0], t.shape[1]
    r = CMP_LEN // CMP_STRIDE
    chunks = t.reshape(B_, S // CMP_STRIDE, CMP_STRIDE, N_KV_HEADS, HEAD_DIM)
    n_cmp = S // CMP_STRIDE - r + 1
    blocks = jnp.concatenate([chunks[:, j:j + n_cmp] for j in range(r)], axis=2)
    blocks = blocks + pos_emb[:, None, :]
    flat = blocks.transpose(0, 1, 3, 2, 4).reshape(B_, n_cmp, N_KV_HEADS, CMP_LEN * HEAD_DIM)
    return jax.nn.silu(flat @ w1) @ w2


def nsa_shared_kv(x, norm_g, w_kv, k_gain, cmp_k_pos, cmp_k_w1, cmp_k_w2,
                  cmp_v_pos, cmp_v_w1, cmp_v_w2):
    B_, S, _ = x.shape
    kv = (rms_norm(x, norm_g) @ w_kv).reshape(B_, S, 2 * N_BRANCH, N_KV_HEADS, HEAD_DIM)
    k_cmp = rms_norm(compress(kv[:, :, 0], cmp_k_pos, cmp_k_w1, cmp_k_w2), k_gain[0])
    v_cmp = compress(kv[:, :, 1], cmp_v_pos, cmp_v_w1, cmp_v_w2)
    k_slc = rms_norm(kv[:, :, 2], k_gain[1])
    v_slc = kv[:, :, 3]
    k_win = rms_norm(kv[:, :, 4], k_gain[2])
    v_win = kv[:, :, 5]
    return k_cmp, v_cmp, k_slc, v_slc, k_win, v_win


def selected_attention(q, k, v, sel_idx, table):
    B_, S = q.shape[0], q.shape[1]
    nsel = S // SEL_BLOCK
    n_top = sel_idx.shape[-1]
    n_keys = n_top * SEL_BLOCK
    kb = k.reshape(B_, nsel, SEL_BLOCK, N_KV_HEADS, HEAD_DIM).transpose(0, 3, 1, 2, 4)
    kb = kb.reshape(B_, N_KV_HEADS, nsel, SEL_BLOCK * HEAD_DIM)
    vb = v.reshape(B_, nsel, SEL_BLOCK, N_KV_HEADS, HEAD_DIM).transpose(0, 3, 1, 2, 4)
    vb = vb.reshape(B_, N_KV_HEADS, nsel, SEL_BLOCK * HEAD_DIM)
    table_t = table.reshape(NUM_BUCKETS, N_KV_HEADS, GROUP).transpose(1, 0, 2)
    head_idx = jnp.arange(N_KV_HEADS)[None, :, None, None]
    offs = jnp.arange(SEL_BLOCK)
    scale = HEAD_DIM ** -0.5

    def chunk(c):
        start = c * SEL_CHUNK
        qc = lax.dynamic_slice_in_dim(q, start, SEL_CHUNK, axis=1)
        ic = lax.dynamic_slice_in_dim(sel_idx, start, SEL_CHUNK, axis=2)
        flat = ic.reshape(B_, N_KV_HEADS, SEL_CHUNK * n_top, 1)
        kg = jnp.take_along_axis(kb, flat, axis=2).reshape(B_, N_KV_HEADS, SEL_CHUNK, n_keys, HEAD_DIM)
        vg = jnp.take_along_axis(vb, flat, axis=2).reshape(B_, N_KV_HEADS, SEL_CHUNK, n_keys, HEAD_DIM)
        kpos = (ic[..., None] * SEL_BLOCK + offs).reshape(B_, N_KV_HEADS, SEL_CHUNK, n_keys)
        dist = (start + jnp.arange(SEL_CHUNK))[None, None, :, None] - kpos
        logits = jnp.einsum('bqhgd,bhqkd->bhgqk', qc, kg,
                            preferred_element_type=jnp.float32) * scale
        bias = jnp.moveaxis(table_t[head_idx, t5_bucket(dist)], -1, 2)
        logits = jnp.where((dist >= 0)[:, :, None], logits + bias, NEG)
        p = jax.nn.softmax(logits, axis=-1)
        return jnp.einsum('bhgqk,bhqkd->bqhgd', p.astype(v.dtype), vg)

    out = lax.map(chunk, jnp.arange(S // SEL_CHUNK))
    return out.transpose(1, 0, 2, 3, 4, 5).reshape(q.shape)


def nsa_layer(x, norm_g, w_in, q_gain, w_out, table, k_cmp, v_cmp, k_slc, v_slc, k_win, v_win):
    B_, S, _ = x.shape
    proj = rms_norm(x, norm_g) @ w_in
    q = rms_norm(proj[..., :HQ].reshape(B_, S, N_KV_HEADS, GROUP, HEAD_DIM), q_gain)
    gate_logits = proj[..., HQ:HQ + N_BRANCH * N_HEADS].reshape(B_, S, N_BRANCH, N_HEADS)
    z = proj[..., HQ + N_BRANCH * N_HEADS:].reshape(B_, S, N_BRANCH, N_HEADS, HEAD_DIM)
    pos = jnp.arange(S)
    scale = HEAD_DIM ** -0.5

    n_cmp = k_cmp.shape[1]
    cmp_start = jnp.arange(n_cmp) * CMP_STRIDE
    dist_c = pos[:, None] - (cmp_start + CMP_LEN - 1)[None, :]
    valid_c = dist_c >= 0
    logits = jnp.einsum('bshgd,bchd->bhgsc', q, k_cmp,
                        preferred_element_type=jnp.float32) * scale
    logits = jnp.where(valid_c, logits + head_bias(table, dist_c), NEG)
    p_cmp = jax.nn.softmax(logits, axis=-1) * valid_c
    o_cmp = jnp.einsum('bhgsc,bchd->bshgd', p_cmp.astype(v_cmp.dtype), v_cmp)

    nsel = S // SEL_BLOCK
    sel_start = jnp.arange(nsel) * SEL_BLOCK
    overlap = ((cmp_start[:, None] < sel_start[None, :] + SEL_BLOCK)
               & (cmp_start[:, None] + CMP_LEN > sel_start[None, :])).astype(jnp.float32)
    imp = jnp.einsum('bhsc,cj->bhsj', p_cmp.sum(axis=2), overlap)
    blk = jnp.arange(nsel)
    causal = sel_start[None, :] <= pos[:, None]
    rel_blk = (pos // SEL_BLOCK)[:, None] - blk[None, :]
    forced = (blk[None, :] == 0) | ((rel_blk >= 0) & (rel_blk < SEL_FORCE_LOCAL))
    score = jnp.where(causal, imp + jnp.where(forced, FORCE_BONUS, 0.0), NEG)
    _, sel_idx = lax.top_k(score, min(SEL_TOP, nsel))
    o_slc = selected_attention(q, k_slc, v_slc, sel_idx, table)

    o_win = banded_attention(q, k_win, v_win, NSA_WINDOW, table, None)

    o_all = jnp.stack([o_cmp, o_slc, o_win], axis=2).reshape(B_, S, N_BRANCH, N_HEADS, HEAD_DIM)
    o = jnp.einsum('bschd,bsch->bshd', o_all * jax.nn.silu(z), jax.nn.sigmoid(gate_logits))
    return x + o.reshape(B_, S, HQ) @ w_out


def setup_inputs(seed: int = 0) -> dict:
    key = jax.random.key(seed)
    ks = jax.random.split(key, 24)
    f32 = jnp.float32
    nrm = lambda k, shape, s: jax.random.normal(k, shape, f32) * s
    return {
        "x": nrm(ks[0], (BATCH, SEQ, D_MODEL), 1.0),
        "rel_table": nrm(ks[1], (NUM_BUCKETS, N_HEADS), 0.5),
        "a_norm": 1.0 + nrm(ks[2], (N_A_LAYERS, D_MODEL), 0.02),
        "a_w_in": nrm(ks[3], (N_A_LAYERS, D_MODEL, A_IN), D_MODEL ** -0.5),
        "a_q_gain": 1.0 + nrm(ks[4], (N_A_LAYERS, HEAD_DIM), 0.02),
        "a_k_gain": 1.0 + nrm(ks[5], (N_A_LAYERS, HEAD_DIM), 0.02),
        "a_sink": nrm(ks[6], (N_A_LAYERS, N_HEADS), 1.0),
        "a_w_out": nrm(ks[7], (N_A_LAYERS, HQ, D_MODEL), HQ ** -0.5),
        "kv_norm": 1.0 + nrm(ks[8], (D_MODEL,), 0.02),
        "kv_w": nrm(ks[9], (D_MODEL, 2 * N_BRANCH * HKV), D_MODEL ** -0.5),
        "kv_k_gain": 1.0 + nrm(ks[10], (N_BRANCH, HEAD_DIM), 0.02),
        "cmp_k_pos": nrm(ks[11], (CMP_LEN, HEAD_DIM), 0.1),
        "cmp_k_w1": nrm(ks[12], (CMP_LEN * HEAD_DIM, CMP_HIDDEN), (CMP_LEN * HEAD_DIM) ** -0.5),
        "cmp_k_w2": nrm(ks[13], (CMP_HIDDEN, HEAD_DIM), CMP_HIDDEN ** -0.5),
        "cmp_v_pos": nrm(ks[14], (CMP_LEN, HEAD_DIM), 0.1),
        "cmp_v_w1": nrm(ks[15], (CMP_LEN * HEAD_DIM, CMP_HIDDEN), (CMP_LEN * HEAD_DIM) ** -0.5),
        "cmp_v_w2": nrm(ks[16], (CMP_HIDDEN, HEAD_DIM), CMP_HIDDEN ** -0.5),
        "b_norm": 1.0 + nrm(ks[17], (N_B_LAYERS, D_MODEL), 0.02),
        "b_w_in": nrm(ks[18], (N_B_LAYERS, D_MODEL, B_IN), D_MODEL ** -0.5),
        "b_q_gain": 1.0 + nrm(ks[19], (N_B_LAYERS, HEAD_DIM), 0.02),
        "b_w_out": nrm(ks[20], (N_B_LAYERS, HQ, D_MODEL), HQ ** -0.5),
    }


def reference(x, rel_table, a_norm, a_w_in, a_q_gain, a_k_gain, a_sink, a_w_out,
              kv_norm, kv_w, kv_k_gain, cmp_k_pos, cmp_k_w1, cmp_k_w2,
              cmp_v_pos, cmp_v_w1, cmp_v_w2, b_norm, b_w_in, b_q_gain, b_w_out):
    shared = None
    for layer in range(DEPTH):
        if layer < N_A_LAYERS:
            x = swa_layer(x, a_norm[layer], a_w_in[layer], a_q_gain[layer], a_k_gain[layer],
                          a_sink[layer], a_w_out[layer], rel_table)
        else:
            if layer == N_A_LAYERS:
                shared = nsa_shared_kv(x, kv_norm, kv_w, kv_k_gain, cmp_k_pos, cmp_k_w1,
                                       cmp_k_w2, cmp_v_pos, cmp_v_w1, cmp_v_w2)
            j = layer - N_A_LAYERS
            x = nsa_layer(x, b_norm[j], b_w_in[j], b_q_gain[j], b_w_out[j], rel_table, *shared)
    return x
```

```cpp
#include <hip/hip_runtime.h>
#include <hip/hip_cooperative_groups.h>
#include <cstdio>
#include <cstdint>
#include <cstring>
namespace cg = cooperative_groups;

#ifndef MEGA
#define MEGA 0
#endif

#define LAS __attribute__((address_space(3)))
typedef unsigned short bf16_t;
typedef short bf16x8 __attribute__((ext_vector_type(8)));
typedef short s16x4 __attribute__((ext_vector_type(4)));
typedef float f32x4 __attribute__((ext_vector_type(4)));
typedef float f32x2 __attribute__((ext_vector_type(2)));
typedef unsigned u32x4 __attribute__((ext_vector_type(4)));
typedef unsigned u32x2 __attribute__((ext_vector_type(2)));
typedef __bf16 bf16x2_t __attribute__((ext_vector_type(2)));

constexpr int T_ = 32768, S_ = 2048, NB_ = 16, D_ = 1024;
constexpr int A_IN = 2560, B_INP = 4224  , KVW = 1536, KVB_N = KVW + B_INP  ;
constexpr float EPS = 1e-6f;
constexpr float LOG2E = 1.4426950408889634f;
constexpr float C1 = 0.125f * LOG2E;
constexpr float NEGBIG = -1e30f;
constexpr int LUTW = 320;

constexpr size_t MiB = 1u << 20;
constexpr size_t WS_LUT = 1 * MiB;
constexpr size_t WS_CB = WS_LUT + 65536;
constexpr size_t WS_PART = 2 * MiB;
constexpr size_t WS_GATES = 4 * MiB;
constexpr size_t WS_WINA = 10 * MiB;
constexpr size_t WS_WOUTA = 20 * MiB;
constexpr size_t WS_WKVB0 = 24 * MiB;
constexpr size_t WS_WINB1 = 36 * MiB;
constexpr size_t WS_WOUTB = 45 * MiB;
constexpr size_t WS_W1 = 49 * MiB;
constexpr size_t WS_W2 = 51 * MiB;
constexpr size_t WS_XB = 52 * MiB;
constexpr size_t WS_KV = 116 * MiB;
constexpr size_t WS_Q = 212 * MiB;
constexpr size_t WS_Z = 276 * MiB;
constexpr size_t WS_HID = 468 * MiB;
constexpr size_t WS_KCMP = 476 * MiB;
constexpr size_t WS_VCMP = 477 * MiB;

struct ConvJob { const float* src; bf16_t* dst; const float* gain; int ldsrc, K, nsrc0, ndst0, ncols, tile0; };
constexpr int MAXJOBS = 32;

struct Params {
    const float *x, *rel_table, *a_norm, *a_w_in, *a_q_gain, *a_k_gain, *a_sink, *a_w_out;
    const float *kv_norm, *kv_w, *kv_k_gain, *cmp_k_pos, *cmp_k_w1, *cmp_k_w2, *cmp_v_pos, *cmp_v_w1, *cmp_v_w2;
    const float *b_norm, *b_w_in, *b_q_gain, *b_w_out;
    float* out;
    char* ws;
    ConvJob jobs[MAXJOBS];
    int njobs, nconv_tiles;
};

__device__ __forceinline__ unsigned pack2(float a, float b) { f32x2 v = {a, b}; bf16x2_t r = __builtin_convertvector(v, bf16x2_t); return __builtin_bit_cast(unsigned, r); }
__device__ __forceinline__ float bflo(unsigned u) { return __uint_as_float(u << 16); }
__device__ __forceinline__ float bfhi(unsigned u) { return __uint_as_float(u & 0xffff0000u); }
__device__ __forceinline__ float fast_exp2(float x) { return __builtin_amdgcn_exp2f(x); }
__device__ __forceinline__ float fast_rcp(float x) { return __builtin_amdgcn_rcpf(x); }
__device__ __forceinline__ float silu_f(float v) { return v * fast_rcp(1.0f + fast_exp2(-v * LOG2E)); }
__device__ __forceinline__ float sigmoid_f(float v) { return fast_rcp(1.0f + fast_exp2(-v * LOG2E)); }
__device__ __forceinline__ f32x4 mfma16(bf16x8 a, bf16x8 b, f32x4 c) { return __builtin_amdgcn_mfma_f32_16x16x32_bf16(a, b, c, 0, 0, 0); }

__device__ __forceinline__ void conv_tile(LAS char* lds, const ConvJob& J, int lt) {
    LAS float* sm = (LAS float*)lds;
    const int tid = threadIdx.x;
    const int ktiles = J.K >> 6;
    const int nt = lt / ktiles, kt = lt - nt * ktiles;
    const int k0 = kt * 64, n0 = nt * 64;
    __syncthreads();
#pragma unroll
    for (int i = 0; i < 4; ++i) {
        const int c = tid + 256 * i, kk = c >> 4, n4 = (c & 15) * 4;
        f32x4 v = {0.f, 0.f, 0.f, 0.f};
        if (J.src && n0 + n4 < J.ncols) v = *(const f32x4*)(J.src + (size_t)(k0 + kk) * J.ldsrc + J.nsrc0 + n0 + n4);
        const float gn = J.gain ? J.gain[k0 + kk] : 1.0f;
        sm[kk * 65 + n4 + 0] = v[0] * gn; sm[kk * 65 + n4 + 1] = v[1] * gn; sm[kk * 65 + n4 + 2] = v[2] * gn; sm[kk * 65 + n4 + 3] = v[3] * gn;
    }
    __syncthreads();
#pragma unroll
    for (int i = 0; i < 2; ++i) {
        const int c = tid + 256 * i, nn = c >> 3, k8 = (c & 7) * 8;
        u32x4 w;
        w[0] = pack2(sm[(k8 + 0) * 65 + nn], sm[(k8 + 1) * 65 + nn]);
        w[1] = pack2(sm[(k8 + 2) * 65 + nn], sm[(k8 + 3) * 65 + nn]);
        w[2] = pack2(sm[(k8 + 4) * 65 + nn], sm[(k8 + 5) * 65 + nn]);
        w[3] = pack2(sm[(k8 + 6) * 65 + nn], sm[(k8 + 7) * 65 + nn]);
        *(u32x4*)(J.dst + (size_t)(J.ndst0 + n0 + nn) * J.K + k0 + k8) = w;
    }
}

__device__ __forceinline__ void phase_prep(const Params& p, LAS char* lds, int bid, int nblk) {
    const int tid = threadIdx.x, lane = tid & 63, wid = tid >> 6;
    const int nconv = p.nconv_tiles;
    const int n_x = T_ / 4, n_lut = 40, n_cb = 32;
    const int total = nconv + n_x + n_lut + n_cb;
    for (int u = bid; u < total; u += nblk) {
        if (u < nconv) {
            int j = 0;
            while (j + 1 < p.njobs && p.jobs[j + 1].tile0 <= u) ++j;
            conv_tile(lds, p.jobs[j], u - p.jobs[j].tile0);
        } else if (u < nconv + n_x) {
            const int row = (u - nconv) * 4 + wid;
            const float* xr = p.x + (size_t)row * D_;
            bf16_t* xb = (bf16_t*)(p.ws + WS_XB) + (size_t)row * D_;
            float ss = 0.f;
#pragma unroll
            for (int i = 0; i < 4; ++i) {
                const f32x4 v = *(const f32x4*)(xr + i * 256 + lane * 4);
                ss += v[0] * v[0] + v[1] * v[1] + v[2] * v[2] + v[3] * v[3];
                u32x2 w; w[0] = pack2(v[0], v[1]); w[1] = pack2(v[2], v[3]);
                *(u32x2*)(xb + i * 256 + lane * 4) = w;
            }
#pragma unroll
            for (int o = 32; o >= 1; o >>= 1) ss += __shfl_xor(ss, o);
            if (lane < 16) ((float*)(p.ws + WS_PART))[(size_t)row * 16 + lane] = (lane == 0) ? ss : 0.f;
        } else if (u < nconv + n_x + n_lut) {
            const int i = (u - nconv - n_x) * 256 + tid;
            const int variant = i / (16 * LUTW), rem = i - variant * 16 * LUTW, h = rem / LUTW, k = rem - h * LUTW;
            const int d = 255 - k;
            float v = NEGBIG;
            if (d >= 0 && (variant == 1 || d < 128)) {
                int bk;
                if (d < 16) bk = d;
                else { const int dc = d > 127 ? 127 : d; bk = 16 + (int)(logf((float)dc * (1.0f / 16.0f)) / logf(8.0f) * 16.0f); if (bk > 31) bk = 31; }
                v = p.rel_table[bk * 16 + h] * LOG2E;
            }
            ((float*)(p.ws + WS_LUT))[i] = v;
        } else {
            const int v = u - nconv - n_x - n_lut;
            const int which = v >> 4, ng = v & 15;
            const float* pos = which ? p.cmp_v_pos : p.cmp_k_pos;
            const float* w1 = which ? p.cmp_v_w1 : p.cmp_k_w1;
            const int nn = tid & 15, ks = tid >> 4;
            const int n = ng * 16 + nn;
            float acc = 0.f;
            for (int k = ks * 128; k < ks * 128 + 128; ++k) acc += pos[k] * w1[(size_t)k * 256 + n];
            LAS float* sm = (LAS float*)lds;
            __syncthreads();
            sm[ks * 16 + nn] = acc;
            __syncthreads();
            if (tid < 16) {
                float s = 0.f;
                for (int q = 0; q < 16; ++q) s += sm[q * 16 + tid];
                ((float*)(p.ws + WS_CB))[which * 256 + ng * 16 + tid] = s;
            }
        }
    }
}

struct ARowLinear { int lda; __device__ __forceinline__ size_t operator()(int row) const { return (size_t)row * lda; } };
struct ARowCmp { int colbase; __device__ __forceinline__ size_t operator()(int row) const {
        const int c = row & 127, bh = row >> 7, h = bh & 3, b = bh >> 2; return (size_t)(b * S_ + 16 * c) * KVW + colbase + h * 64; } };

constexpr int LDS_RS = 65536;

template <class ARow, class Epi>
__device__ __forceinline__ void gemm_tile(LAS char* lds, const bf16_t* __restrict__ A, const ARow arow, const int a_kstride,
                                          const bf16_t* __restrict__ Wt, const int K, const int tm, const int tn, const Epi& epi) {
    const int tid = threadIdx.x, lane = tid & 63, wid = tid >> 6, wr = wid >> 1, wc = wid & 1, l15 = lane & 15, g = lane >> 4;
    const bf16_t* ap[4]; const bf16_t* wp[4]; int loff[4];
#pragma unroll
    for (int i = 0; i < 4; ++i) {
        const int c = tid + 256 * i, row = c >> 3, ch = c & 7;
        ap[i] = A + arow(tm * 128 + row) + ch * 8;
        wp[i] = Wt + (size_t)(tn * 128 + row) * K + ch * 8;
        loff[i] = row * 128 + ((ch ^ ((row >> 1) & 7)) << 4);
    }
    __syncthreads();
    epi.prologue(lds, tm);
    u32x4 ra[4], rw[4];
    f32x4 acc[4][4];
#pragma unroll
    for (int i = 0; i < 4; ++i)
#pragma unroll
        for (int j = 0; j < 4; ++j) acc[i][j] = (f32x4){0.f, 0.f, 0.f, 0.f};
    const int nk = K >> 6;
#pragma unroll
    for (int i = 0; i < 4; ++i) { ra[i] = *(const u32x4*)(ap[i]); rw[i] = *(const u32x4*)(wp[i]); }
#pragma unroll
    for (int i = 0; i < 4; ++i) { *(LAS u32x4*)(lds + loff[i]) = ra[i]; *(LAS u32x4*)(lds + 16384 + loff[i]) = rw[i]; }
    __syncthreads();
    for (int kt = 0; kt < nk; ++kt) {
        const bool more = kt + 1 < nk;
        if (more) {
#pragma unroll
            for (int i = 0; i < 4; ++i) { ra[i] = *(const u32x4*)(ap[i] + (size_t)(kt + 1) * a_kstride); rw[i] = *(const u32x4*)(wp[i] + (kt + 1) * 64); }
        }
        LAS char* xb = lds + (kt & 1) * 32768; LAS char* wb = xb + 16384;
#pragma unroll
        for (int kk = 0; kk < 2; ++kk) {
            bf16x8 xf[4], wf[4];
            const int sw = ((kk * 4 + g) ^ (l15 >> 1)) << 4;
#pragma unroll
            for (int mt = 0; mt < 4; ++mt) xf[mt] = *(LAS bf16x8*)(xb + (wr * 64 + mt * 16 + l15) * 128 + sw);
#pragma unroll
            for (int nt = 0; nt < 4; ++nt) wf[nt] = *(LAS bf16x8*)(wb + (wc * 64 + nt * 16 + l15) * 128 + sw);
#pragma unroll
            for (int mt = 0; mt < 4; ++mt)
#pragma unroll
                for (int nt = 0; nt < 4; ++nt) acc[mt][nt] = mfma16(wf[nt], xf[mt], acc[mt][nt]);
        }
        if (more) {
            LAS char* nb = lds + ((kt + 1) & 1) * 32768;
#pragma unroll
            for (int i = 0; i < 4; ++i) { *(LAS u32x4*)(nb + loff[i]) = ra[i]; *(LAS u32x4*)(nb + 16384 + loff[i]) = rw[i]; }
        }
        __syncthreads();
    }
    epi(acc, lds, tm, tn, wr, wc, l15, g);
}

enum { M_PLAIN = 0, M_NORM = 1, M_SIGM = 2, M_SKIP = 3, M_SILUB = 4, M_NORMZ = 5  , M_PLAINZ = 6 };
struct GroupInfo { int mode; bf16_t* dst; int ld; const float* aux; float* fdst; };

template <class GroupFn>
struct EpiProj {
    const float* part;
    GroupFn gf;
    __device__ __forceinline__ void prologue(LAS char* lds, int tm) const {
        if (part) {
            const int tid = threadIdx.x;
            if (tid < 128) {
                const float* pr = part + (size_t)(tm * 128 + tid) * 16;
                float s = 0.f;
#pragma unroll
                for (int i = 0; i < 4; ++i) { const f32x4 v = *(const f32x4*)(pr + i * 4); s += (v[0] + v[1]) + (v[2] + v[3]); }
                ((LAS float*)(lds + LDS_RS))[tid] = rsqrtf(s * (1.0f / D_) + EPS);
            }
        }
    }
    __device__ __forceinline__ void operator()(f32x4 (&acc)[4][4], LAS char* lds, int tm, int tn, int wr, int wc, int l15, int g) const {
        const GroupInfo gi = gf(tn * 2 + wc);
        if (gi.mode == M_SKIP) return;
#pragma unroll
        for (int mt = 0; mt < 4; ++mt) {
            const int lrow = wr * 64 + mt * 16 + l15;
            const int row = tm * 128 + lrow;
            const float rs = part ? ((LAS float*)(lds + LDS_RS))[lrow] : 1.0f;
            f32x4 v[4];
#pragma unroll
            for (int nt = 0; nt < 4; ++nt) v[nt] = acc[mt][nt] * rs;
            if (gi.mode == M_NORM || gi.mode == M_NORMZ) {
                float ss = 0.f;
#pragma unroll
                for (int nt = 0; nt < 4; ++nt) ss += (v[nt][0] * v[nt][0] + v[nt][1] * v[nt][1]) + (v[nt][2] * v[nt][2] + v[nt][3] * v[nt][3]);
                ss += __shfl_xor(ss, 16); ss += __shfl_xor(ss, 32);
                const float inv = rsqrtf(ss * (1.0f / 64.0f) + EPS);
#pragma unroll
                for (int nt = 0; nt < 4; ++nt) { const f32x4 gn = *(const f32x4*)(gi.aux + nt * 16 + 4 * g); v[nt] = v[nt] * inv * gn; }
            } else if (gi.mode == M_SILUB) {
#pragma unroll
                for (int nt = 0; nt < 4; ++nt) { const f32x4 bb = *(const f32x4*)(gi.aux + nt * 16 + 4 * g);
#pragma unroll
                    for (int r = 0; r < 4; ++r) v[nt][r] = silu_f(v[nt][r] + bb[r]); }
            }
            if (gi.mode == M_NORMZ || gi.mode == M_PLAINZ) {
                if ((row & 127) == 127) {
#pragma unroll
                    for (int nt = 0; nt < 4; ++nt) v[nt] = (f32x4){0.f, 0.f, 0.f, 0.f};
                }
            }
            if (gi.mode == M_SIGM) {
#pragma unroll
                for (int nt = 0; nt < 3; ++nt) { f32x4 sg;
#pragma unroll
                    for (int r = 0; r < 4; ++r) sg[r] = sigmoid_f(v[nt][r]);
                    *(f32x4*)(gi.fdst + (size_t)row * 48 + nt * 16 + 4 * g) = sg; }
            } else {
#pragma unroll
                for (int nt = 0; nt < 4; ++nt) { u32x2 w; w[0] = pack2(v[nt][0], v[nt][1]); w[1] = pack2(v[nt][2], v[nt][3]);
                    *(u32x2*)(gi.dst + (size_t)row * gi.ld + nt * 16 + 4 * g) = w; }
            }
        }
    }
};

struct EpiOut {
    const float* xold; float* xnew; bf16_t* xb; float* part;
    __device__ __forceinline__ void prologue(LAS char*, int) const {}
    __device__ __forceinline__ void operator()(f32x4 (&acc)[4][4], LAS char*, int tm, int tn, int wr, int wc, int l15, int g) const {
#pragma unroll
        for (int mt = 0; mt < 4; ++mt) {
            const int row = tm * 128 + wr * 64 + mt * 16 + l15;
            float ss = 0.f;
#pragma unroll
            for (int nt = 0; nt < 4; ++nt) {
                const size_t off = (size_t)row * D_ + tn * 128 + wc * 64 + nt * 16 + 4 * g;
                const f32x4 xo = *(const f32x4*)(xold + off);
                const f32x4 xn = xo + acc[mt][nt];
                *(f32x4*)(xnew + off) = xn;
                u32x2 w; w[0] = pack2(xn[0], xn[1]); w[1] = pack2(xn[2], xn[3]);
                *(u32x2*)(xb + off) = w;
                ss += (xn[0] * xn[0] + xn[1] * xn[1]) + (xn[2] * xn[2] + xn[3] * xn[3]);
            }
            ss += __shfl_xor(ss, 16); ss += __shfl_xor(ss, 32);
            if (g == 0) part[(size_t)row * 16 + tn * 2 + wc] = ss;
        }
    }
};

struct GfA {
    bf16_t* proj; const float* qg; const float* kg;
    __device__ __forceinline__ GroupInfo operator()(int G) const {
        GroupInfo gi; gi.dst = proj + G * 64; gi.ld = A_IN; gi.fdst = nullptr; gi.aux = nullptr; gi.mode = M_PLAIN;
        if (G < 16) { gi.mode = M_NORM; gi.aux = qg; } else if (G < 20) { gi.mode = M_NORM; gi.aux = kg; }
        return gi;
    }
};
struct GfB {
    int kvgroups; bf16_t* kv; const float* kvg; bf16_t* q; bf16_t* z; float* gates; const float* qg;
    __device__ __forceinline__ GroupInfo operator()(int G) const {
        GroupInfo gi; gi.fdst = nullptr; gi.aux = nullptr; gi.mode = M_PLAIN; gi.dst = nullptr; gi.ld = 0;
        if (G < kvgroups) {
            gi.dst = kv + G * 64; gi.ld = KVW;
            const int s = G >> 2;
            if (s == 2) { gi.mode = M_NORM; gi.aux = kvg + 64; } else if (s == 4) { gi.mode = M_NORM; gi.aux = kvg + 128; }
            return gi;
        }
        const int Gp = G - kvgroups;
        if (Gp < 16) { gi.mode = M_NORM; gi.aux = qg; gi.dst = q + Gp * 64; gi.ld = D_; }
        else if (Gp < 64) { gi.dst = z + (Gp - 16) * 64; gi.ld = 3072; }
        else if (Gp == 64) { gi.mode = M_SIGM; gi.fdst = gates; }
        else gi.mode = M_SKIP;
        return gi;
    }
};
struct GfC1 {
    bf16_t* hid; const float* cb;
    __device__ __forceinline__ GroupInfo operator()(int G) const { GroupInfo gi; gi.mode = M_SILUB; gi.dst = hid + G * 64; gi.ld = 256; gi.aux = cb + G * 64; gi.fdst = nullptr; return gi; }
};
struct GfC2 {
    bf16_t* dst; const float* gain; int isk;
    __device__ __forceinline__ GroupInfo operator()(int G) const { GroupInfo gi; gi.dst = dst; gi.ld = 64; gi.aux = gain; gi.fdst = nullptr;
        gi.mode = (G != 0) ? M_SKIP : (isk ? M_NORMZ : M_PLAINZ); return gi; }
};

constexpr int LDS_K = 0, LDS_V = 16384, LDS_LUT = 32768;

__device__ __forceinline__ void stage_rows(int tid, LAS char* dst, const bf16_t* src, size_t ld, int nrows, bool vswz) {
    const int row0 = tid >> 3, ch = tid & 7;
    const int sc = vswz ? (ch ^ (((row0 >> 1) & 3) << 1)) : (ch ^ ((row0 >> 1) & 7));
    LAS char* d0 = dst + row0 * 128 + (sc << 4);
    const bf16_t* s0 = src + (size_t)row0 * ld + ch * 8;
    if (nrows == 64) {
        const u32x4 v0 = *(const u32x4*)(s0), v1 = *(const u32x4*)(s0 + 32 * ld);
        *(LAS u32x4*)(d0) = v0; *(LAS u32x4*)(d0 + 4096) = v1;
    } else {
        const u32x4 v0 = *(const u32x4*)(s0), v1 = *(const u32x4*)(s0 + 32 * ld), v2 = *(const u32x4*)(s0 + 64 * ld), v3 = *(const u32x4*)(s0 + 96 * ld);
        *(LAS u32x4*)(d0) = v0; *(LAS u32x4*)(d0 + 4096) = v1; *(LAS u32x4*)(d0 + 8192) = v2; *(LAS u32x4*)(d0 + 12288) = v3;
    }
}

__device__ __forceinline__ bf16x8 read_kfrag(LAS const char* Kb, int rowbase, int kk, int l15, int g) {
    return *(LAS const bf16x8*)(Kb + (rowbase + l15) * 128 + (((kk * 4 + g) ^ (l15 >> 1)) << 4));
}
__device__ __forceinline__ bf16x8 read_vfrag(LAS const char* Vb, int rowbase, int dt, int l15, int g) {
    const int p = l15 & 3;
    const int sw = ((2 * dt + (p >> 1)) ^ (((2 * g + (l15 >> 3)) & 3) << 1)) << 4;
    const int r0 = rowbase + 4 * g + (l15 >> 2);
    LAS const char* a0 = Vb + r0 * 128 + sw + (p & 1) * 8;
    const s16x4 lo = __builtin_bit_cast(s16x4, __builtin_amdgcn_ds_read_tr16_b64_v4i16((LAS s16x4*)a0));
    const s16x4 hi = __builtin_bit_cast(s16x4, __builtin_amdgcn_ds_read_tr16_b64_v4i16((LAS s16x4*)(a0 + 16 * 128)));
    return (bf16x8){lo[0], lo[1], lo[2], lo[3], hi[0], hi[1], hi[2], hi[3]};
}

template <bool NEAR, bool WMASK, bool LOFF>
__device__ __forceinline__ void attend32(LAS const char* Kb, LAS const char* Vb, int rowbase, const bf16x8 (&qf)[4][2], f32x4 (&o)[4][4],
                                         float (&m)[4], float (&l)[4], LAS const float* lutp, int dist0, float laneoff,
                                         const float (&cfar)[4], int l15, int g) {
    bf16x8 kf[2][2];
#pragma unroll
    for (int kt = 0; kt < 2; ++kt)
#pragma unroll
        for (int kk = 0; kk < 2; ++kk) kf[kt][kk] = read_kfrag(Kb, rowbase + 16 * kt, kk, l15, g);
    bf16x8 pf[4];
#pragma unroll
    for (int h = 0; h < 4; ++h) {
        f32x4 sh[2];
#pragma unroll
        for (int kt = 0; kt < 2; ++kt) {
            sh[kt] = mfma16(kf[kt][0], qf[h][0], (f32x4){0.f, 0.f, 0.f, 0.f});
            sh[kt] = mfma16(kf[kt][1], qf[h][1], sh[kt]);
        }
        float t[2][4];
        float mx = NEGBIG;
#pragma unroll
        for (int kt = 0; kt < 2; ++kt)
#pragma unroll
            for (int r = 0; r < 4; ++r) {
                float bias;
                if (NEAR) bias = lutp[h * LUTW + 16 * kt + r]; else bias = cfar[h];
                float tv = sh[kt][r] * C1 + bias;
                if (LOFF) tv += laneoff;
                if (WMASK) { const int d = dist0 - 16 * kt - r; tv = (d >= 512) ? NEGBIG : tv; }
                t[kt][r] = tv;
                mx = fmaxf(mx, tv);
            }
        mx = fmaxf(mx, __shfl_xor(mx, 16)); mx = fmaxf(mx, __shfl_xor(mx, 32));
        const float mn = fmaxf(m[h], mx);
        const float alpha = fast_exp2(m[h] - mn);
        m[h] = mn;
        float ls = 0.f;
#pragma unroll
        for (int kt = 0; kt < 2; ++kt)
#pragma unroll
            for (int r = 0; r < 4; ++r) { t[kt][r] = fast_exp2(t[kt][r] - mn); ls += t[kt][r]; }
        l[h] = l[h] * alpha + ls;
#pragma unroll
        for (int dt = 0; dt < 4; ++dt) o[h][dt] = o[h][dt] * alpha;
        u32x4 pw; pw[0] = pack2(t[0][0], t[0][1]); pw[1] = pack2(t[0][2], t[0][3]); pw[2] = pack2(t[1][0], t[1][1]); pw[3] = pack2(t[1][2], t[1][3]);
        pf[h] = __builtin_bit_cast(bf16x8, pw);
    }
    __builtin_amdgcn_sched_barrier(0);
#pragma unroll
    for (int dt = 0; dt < 4; ++dt) {
        const bf16x8 vf = read_vfrag(Vb, rowbase, dt, l15, g);
#pragma unroll
        for (int h = 0; h < 4; ++h) o[h][dt] = mfma16(vf, pf[h], o[h][dt]);
    }
    __builtin_amdgcn_sched_barrier(0);
}

__device__ __forceinline__ void load_qfrags(bf16x8 (&qf)[4][2], const bf16_t* qrow  , int g) {
#pragma unroll
    for (int h = 0; h < 4; ++h)
#pragma unroll
        for (int kk = 0; kk < 2; ++kk) qf[h][kk] = *(const bf16x8*)(qrow + h * 64 + kk * 32 + 8 * g);
}

__device__ __forceinline__ void build_lut(int tid, LAS char* lds, const float* lutg, int kvh, int variant) {
    const float* src = lutg + (size_t)(variant * 4 + kvh) * (4 * LUTW) + tid;
    LAS float* dst = (LAS float*)(lds + LDS_LUT) + tid;
#pragma unroll
    for (int i = 0; i < 5; ++i) dst[i * 256] = src[i * 256];
}

__device__ __forceinline__ void phase_attn_a(const Params& p, LAS char* lds, int bid, int nblk, int layer) {
    const bf16_t* proj = (const bf16_t*)(p.ws + WS_Q);
    bf16_t* O = (bf16_t*)(p.ws + WS_KV);
    const float* lutg = (const float*)(p.ws + WS_LUT);
    LAS const float* lut = (LAS const float*)(lds + LDS_LUT);
    const float cfar[4] = {0.f, 0.f, 0.f, 0.f};
    for (int it = bid; it < 2048; it += nblk) {
        int tid = threadIdx.x;
        asm volatile("" : "+v"(tid));
        const int lane = tid & 63, w = tid >> 6, l15 = lane & 15, g = lane >> 4;
        const int jq = 31 - (it >> 6), bh = it & 63, b = bh >> 2, kvh = bh & 3;
        const int qi = 16 * w + l15;
        const size_t tg = (size_t)b * S_ + jq * 64 + qi;
        __syncthreads();
        build_lut(tid, lds, lutg, kvh, 0);
        bf16x8 qf[4][2];
        load_qfrags(qf, proj + tg * A_IN + kvh * 256, g);
        f32x4 o[4][4]; float m[4], l[4];
#pragma unroll
        for (int h = 0; h < 4; ++h) {
            m[h] = p.a_sink[layer * 16 + kvh * 4 + h] * LOG2E; l[h] = (g == 0) ? 1.0f : 0.0f;
#pragma unroll
            for (int dt = 0; dt < 4; ++dt) o[h][dt] = (f32x4){0.f, 0.f, 0.f, 0.f};
        }
        const int ndj = jq < 2 ? jq + 1 : 3;
        for (int dj = 0; dj < ndj; ++dj) {
            const int jk = jq - dj;
            __syncthreads();
            const bf16_t* krow = proj + ((size_t)b * S_ + jk * 64) * A_IN + 1024 + kvh * 64;
            stage_rows(tid, lds + LDS_K, krow, A_IN, 64, false);
            stage_rows(tid, lds + LDS_V, krow + 256, A_IN, 64, true);
            __syncthreads();
            const int dist0 = dj * 64 + qi - 4 * g;
            LAS const float* lutp = lut + (255 - dist0);
#pragma unroll 1
            for (int sub = 0; sub < 2; ++sub)
                attend32<true, false, false>(lds + LDS_K + sub * 4096, lds + LDS_V + sub * 4096, 0, qf, o, m, l, lutp + 32 * sub, dist0 - 32 * sub, 0.f, cfar, l15, g);
        }
#pragma unroll
        for (int h = 0; h < 4; ++h) {
            float lt = l[h]; lt += __shfl_xor(lt, 16); lt += __shfl_xor(lt, 32);
            const float inv = 1.0f / lt;
#pragma unroll
            for (int dt = 0; dt < 4; ++dt) {
                const int col = (kvh * 4 + h) * 64 + 16 * dt + 4 * g;
                const u32x2 zz = *(const u32x2*)(proj + tg * A_IN + 1536 + col);
                const float z0 = bflo(zz[0]), z1 = bfhi(zz[0]), z2 = bflo(zz[1]), z3 = bfhi(zz[1]);
                u32x2 wv;
                wv[0] = pack2(o[h][dt][0] * inv * silu_f(z0), o[h][dt][1] * inv * silu_f(z1));
                wv[1] = pack2(o[h][dt][2] * inv * silu_f(z2), o[h][dt][3] * inv * silu_f(z3));
                *(u32x2*)(O + tg * D_ + col) = wv;
            }
        }
    }
}

__device__ __forceinline__ void gate_store1(bf16_t* orow  , const f32x4 (&o)[4], float gs, const bf16_t* zrow  , int g, bool first) {
#pragma unroll
    for (int dt = 0; dt < 4; ++dt) {
        const u32x2 zz = *(const u32x2*)(zrow + 16 * dt + 4 * g);
        float v0 = o[dt][0] * gs * silu_f(bflo(zz[0]));
        float v1 = o[dt][1] * gs * silu_f(bfhi(zz[0]));
        float v2 = o[dt][2] * gs * silu_f(bflo(zz[1]));
        float v3 = o[dt][3] * gs * silu_f(bfhi(zz[1]));
        if (!first) { const u32x2 pv = *(const u32x2*)(orow + 16 * dt + 4 * g); v0 += bflo(pv[0]); v1 += bfhi(pv[0]); v2 += bflo(pv[1]); v3 += bfhi(pv[1]); }
        u32x2 wv; wv[0] = pack2(v0, v1); wv[1] = pack2(v2, v3);
        *(u32x2*)(orow + 16 * dt + 4 * g) = wv;
    }
}

__device__ __forceinline__ void phase_attn_b(const Params& p, LAS char* lds, int bid, int nblk) {
    const bf16_t* Q = (const bf16_t*)(p.ws + WS_Q);
    const bf16_t* Z = (const bf16_t*)(p.ws + WS_Z);
    const bf16_t* KV = (const bf16_t*)(p.ws + WS_KV);
    const bf16_t* KC = (const bf16_t*)(p.ws + WS_KCMP);
    const bf16_t* VC = (const bf16_t*)(p.ws + WS_VCMP);
    const float* GT = (const float*)(p.ws + WS_GATES);
    const float* lutg = (const float*)(p.ws + WS_LUT);
    LAS const float* lut = (LAS const float*)(lds + LDS_LUT);
    for (int it = bid; it < 2048; it += nblk) {
        int tid = threadIdx.x;
        asm volatile("" : "+v"(tid));
        const int lane = tid & 63, w = tid >> 6, l15 = lane & 15, g = lane >> 4;
        const int jq = 31 - (it >> 6), bh = it & 63, b = bh >> 2, kvh = bh & 3;
        const int qi = 16 * w + l15;
        const int qpos = jq * 64 + qi;
        const size_t tg = (size_t)b * S_ + qpos;
        __syncthreads();
        build_lut(tid, lds, lutg, kvh, 1);
        stage_rows(tid, lds + LDS_K, KC + (size_t)(b * 4 + kvh) * 128 * 64, 64, 128, false);
        stage_rows(tid, lds + LDS_V, VC + (size_t)(b * 4 + kvh) * 128 * 64, 64, 128, true);
        const bf16_t* zrow = Z + tg * 3072 + kvh * 256;
        const float* grow = GT + tg * 48 + kvh * 4;
        bf16_t* orow = (bf16_t*)(p.ws + WS_Z) + tg * 3072 + kvh * 256;
        float cfar[4];
        __syncthreads();
#pragma unroll
        for (int h = 0; h < 4; ++h) cfar[h] = lut[h * LUTW + 128];
        f32x4 psum[8];
#pragma unroll
        for (int kt = 0; kt < 8; ++kt) psum[kt] = (f32x4){0.f, 0.f, 0.f, 0.f};
        const bool rowvalid = qpos >= 31;
        const int nck = ((4 * jq + 2) >> 5) + 1;
        const bf16_t* qrow = Q + tg * D_ + kvh * 256;
#pragma unroll 1
        for (int h = 0; h < 4; ++h) {
            const bf16x8 q0 = *(const bf16x8*)(qrow + h * 64 + 8 * g), q1 = *(const bf16x8*)(qrow + h * 64 + 32 + 8 * g);
            LAS const float* luth = lut + h * LUTW;
            float ml = NEGBIG, ll = 0.f;
#pragma unroll
            for (int ck = 0; ck < 4; ++ck) {
                if (ck < nck) {
                    float t[2][4]; float cm = NEGBIG;
#pragma unroll
                    for (int kt = 0; kt < 2; ++kt) {
                        f32x4 sv = mfma16(read_kfrag(lds + LDS_K, 32 * ck + 16 * kt, 0, l15, g), q0, (f32x4){0.f, 0.f, 0.f, 0.f});
                        sv = mfma16(read_kfrag(lds + LDS_K, 32 * ck + 16 * kt, 1, l15, g), q1, sv);
#pragma unroll
                        for (int r = 0; r < 4; ++r) {
                            int d = qpos - 31 - 16 * (32 * ck + 16 * kt + 4 * g + r);
                            d = d < -1 ? -1 : (d > 255 ? 255 : d);
                            t[kt][r] = sv[r] * C1 + luth[255 - d]; cm = fmaxf(cm, t[kt][r]);
                        }
                    }
                    const float mn = fmaxf(ml, cm);
                    float ls = 0.f;
#pragma unroll
                    for (int kt = 0; kt < 2; ++kt)
#pragma unroll
                        for (int r = 0; r < 4; ++r) ls += fast_exp2(t[kt][r] - mn);
                    ll = ll * fast_exp2(ml - mn) + ls; ml = mn;
                }
            }
            float mrow = fmaxf(ml, __shfl_xor(ml, 16)); mrow = fmaxf(mrow, __shfl_xor(mrow, 32));
            ll = ll * fast_exp2(ml - mrow); ll += __shfl_xor(ll, 16); ll += __shfl_xor(ll, 32);
            const float inv = rowvalid ? 1.0f / ll : 0.0f;
            f32x4 oc[4];
#pragma unroll
            for (int dt = 0; dt < 4; ++dt) oc[dt] = (f32x4){0.f, 0.f, 0.f, 0.f};
#pragma unroll
            for (int ck = 0; ck < 4; ++ck) {
                if (ck < nck) {
                    float t[2][4];
#pragma unroll
                    for (int kt = 0; kt < 2; ++kt) {
                        f32x4 sv = mfma16(read_kfrag(lds + LDS_K, 32 * ck + 16 * kt, 0, l15, g), q0, (f32x4){0.f, 0.f, 0.f, 0.f});
                        sv = mfma16(read_kfrag(lds + LDS_K, 32 * ck + 16 * kt, 1, l15, g), q1, sv);
#pragma unroll
                        for (int r = 0; r < 4; ++r) {
                            int d = qpos - 31 - 16 * (32 * ck + 16 * kt + 4 * g + r);
                            d = d < -1 ? -1 : (d > 255 ? 255 : d);
                            t[kt][r] = fast_exp2(sv[r] * C1 + luth[255 - d] - mrow) * inv;
                            psum[2 * ck + kt][r] += t[kt][r];
                        }
                    }
                    u32x4 pw; pw[0] = pack2(t[0][0], t[0][1]); pw[1] = pack2(t[0][2], t[0][3]); pw[2] = pack2(t[1][0], t[1][1]); pw[3] = pack2(t[1][2], t[1][3]);
                    const bf16x8 pfr = __builtin_bit_cast(bf16x8, pw);
#pragma unroll
                    for (int dt = 0; dt < 4; ++dt) oc[dt] = mfma16(read_vfrag(lds + LDS_V, 32 * ck, dt, l15, g), pfr, oc[dt]);
                }
            }
            gate_store1(orow + h * 64, oc, grow[h], zrow + h * 64, g, true);
        }
        unsigned selbits;
        {
            float imp[8];
            const int src = (lane - 16) & 63;
#pragma unroll
            for (int kt = 0; kt < 8; ++kt) {
                const float own = (psum[kt][0] + psum[kt][1]) + (psum[kt][2] + psum[kt][3]);
                const float pa = __shfl(psum[kt][3], src);
                const float pb = (kt > 0) ? __shfl(psum[kt > 0 ? kt - 1 : 0][3], src) : 0.f;
                imp[kt] = own + (g > 0 ? pa : pb);
            }
            if (jq <= 7) {
                selbits = (2u << jq) - 1u;
            } else {
                selbits = 1u | (1u << jq) | (1u << (jq - 1));
                float cand[8];
#pragma unroll
                for (int kt = 0; kt < 8; ++kt) { const int j = 4 * kt + g; cand[kt] = (j >= 1 && j <= jq - 2) ? imp[kt] : -INFINITY; }
                for (int itn = 0; itn < 5; ++itn) {
                    float bv = -INFINITY; int bj = 99;
#pragma unroll
                    for (int kt = 0; kt < 8; ++kt) { if (cand[kt] > bv) { bv = cand[kt]; bj = 4 * kt + g; } }
#pragma unroll
                    for (int x = 16; x <= 32; x <<= 1) {
                        const float ov = __shfl_xor(bv, x); const int oj = __shfl_xor(bj, x);
                        if (ov > bv || (ov == bv && oj < bj)) { bv = ov; bj = oj; }
                    }
                    if (bj < 32) selbits |= 1u << bj;
#pragma unroll
                    for (int kt = 0; kt < 8; ++kt) { if (4 * kt + g == bj) cand[kt] = -INFINITY; }
                }
            }
        }
        bf16x8 qf[4][2];
        load_qfrags(qf, qrow, g);
        f32x4 o[4][4]; float m[4], l[4];
        for (int br = 0; br < 2; ++br) {
#pragma unroll
            for (int h = 0; h < 4; ++h) { m[h] = NEGBIG; l[h] = 0.f;
#pragma unroll
                for (int dt = 0; dt < 4; ++dt) o[h][dt] = (f32x4){0.f, 0.f, 0.f, 0.f}; }
            const int kcol = (br == 0 ? 512 : 1024) + kvh * 64;
            const int jlo = (br == 0) ? 0 : (jq - 8 < 0 ? 0 : jq - 8);
            for (int jk = jq; jk >= jlo; --jk) {
                const int dj = jq - jk;
                __syncthreads();
                const bf16_t* krow = KV + ((size_t)b * S_ + jk * 64) * KVW + kcol;
                stage_rows(tid, lds + LDS_K, krow, KVW, 64, false);
                stage_rows(tid, lds + LDS_V, krow + 256, KVW, 64, true);
                __syncthreads();
                const int dist0 = dj * 64 + qi - 4 * g;
                const float loff = (br == 0) ? (((selbits >> jk) & 1u) ? 0.f : NEGBIG) : 0.f;
                LAS const float* lutp = lut + (255 - dist0);
#pragma unroll 1
                for (int sub = 0; sub < 2; ++sub) {
                    LAS const char* Kb = lds + LDS_K + sub * 4096; LAS const char* Vb = lds + LDS_V + sub * 4096;
                    if (dj <= 2) attend32<true, false, true>(Kb, Vb, 0, qf, o, m, l, lutp + 32 * sub, dist0 - 32 * sub, loff, cfar, l15, g);
                    else if (br == 1 && dj == 8) attend32<false, true, false>(Kb, Vb, 0, qf, o, m, l, lut, dist0 - 32 * sub, loff, cfar, l15, g);
                    else attend32<false, false, true>(Kb, Vb, 0, qf, o, m, l, lut, dist0 - 32 * sub, loff, cfar, l15, g);
                }
            }
#pragma unroll
            for (int h = 0; h < 4; ++h) {
                float lt = l[h]; lt += __shfl_xor(lt, 16); lt += __shfl_xor(lt, 32);
                gate_store1(orow + h * 64, o[h], grow[(br + 1) * 16 + h] / lt, zrow + (br + 1) * 1024 + h * 64, g, false);
            }
        }
    }
}

constexpr int NPHASE = 15;
__device__ __forceinline__ void run_phase(const Params& p, LAS char* lds, int ph, int bid, int nblk) {
    char* ws = p.ws;
    const float* part = (const float*)(ws + WS_PART);
    if (ph == 0) { phase_prep(p, lds, bid, nblk); return; }
    if (ph == 1 || ph == 4) {
        const int L = (ph == 1) ? 0 : 1;
        EpiProj<GfA> epi{part, GfA{(bf16_t*)(ws + WS_Q), p.a_q_gain + L * 64, p.a_k_gain + L * 64}};
        const bf16_t* Wt = (const bf16_t*)(ws + WS_WINA) + (size_t)L * A_IN * D_;
        const int ntn = A_IN / 128;
        for (int t = bid; t < 256 * ntn; t += nblk) gemm_tile(lds, (const bf16_t*)(ws + WS_XB), ARowLinear{D_}, 64, Wt, D_, t / ntn, t % ntn, epi);
        return;
    }
    if (ph == 2 || ph == 5) { phase_attn_a(p, lds, bid, nblk, ph == 2 ? 0 : 1); return; }
    if (ph == 3 || ph == 6 || ph == 11 || ph == 14) {
        const bf16_t* A; int lda; const bf16_t* Wt; const float* xold;
        if (ph == 3) { A = (const bf16_t*)(ws + WS_KV); Wt = (const bf16_t*)(ws + WS_WOUTA); xold = p.x; }
        else { A = (const bf16_t*)(ws + WS_KV); Wt = (const bf16_t*)(ws + WS_WOUTA) + (size_t)D_ * D_; xold = p.out; }
        lda = D_;
        if (ph == 11) { A = (const bf16_t*)(ws + WS_Z); Wt = (const bf16_t*)(ws + WS_WOUTB); xold = p.out; lda = 3072; }
        else if (ph == 14) { A = (const bf16_t*)(ws + WS_Z); Wt = (const bf16_t*)(ws + WS_WOUTB) + (size_t)D_ * D_; xold = p.out; lda = 3072; }
        EpiOut epi{xold, p.out, (bf16_t*)(ws + WS_XB), (float*)(ws + WS_PART)};
        for (int t = bid; t < 256 * 8; t += nblk) gemm_tile(lds, A, ARowLinear{lda}, 64, Wt, D_, t >> 3, t & 7, epi);
        return;
    }
    if (ph == 7 || ph == 12) {
        const int kvg = (ph == 7) ? 24 : 0;
        const int L = (ph == 7) ? 0 : 1;
        EpiProj<GfB> epi{part, GfB{kvg, (bf16_t*)(ws + WS_KV), p.kv_k_gain, (bf16_t*)(ws + WS_Q), (bf16_t*)(ws + WS_Z), (float*)(ws + WS_GATES), p.b_q_gain + L * 64}};
        const bf16_t* Wt = (const bf16_t*)(ws + (ph == 7 ? WS_WKVB0 : WS_WINB1));
        const int ntn = (ph == 7 ? KVB_N : B_INP) / 128;
        for (int t = bid; t < 256 * ntn; t += nblk) gemm_tile(lds, (const bf16_t*)(ws + WS_XB), ARowLinear{D_}, 64, Wt, D_, t / ntn, t % ntn, epi);
        return;
    }
    if (ph == 8) {
        for (int t = bid; t < 2 * 64 * 2; t += nblk) {
            const int which = t >> 7, tt = t & 127, tm = tt >> 1, tn = tt & 1;
            EpiProj<GfC1> epi{nullptr, GfC1{(bf16_t*)(ws + WS_HID) + (size_t)which * 8192 * 256, (const float*)(ws + WS_CB) + which * 256}};
            gemm_tile(lds, (const bf16_t*)(ws + WS_KV), ARowCmp{which * 256}, KVW, (const bf16_t*)(ws + WS_W1) + (size_t)which * 256 * 2048, 2048, tm, tn, epi);
        }
        return;
    }
    if (ph == 9) {
        for (int t = bid; t < 2 * 64; t += nblk) {
            const int which = t >> 6, tm = t & 63;
            EpiProj<GfC2> epi{nullptr, GfC2{(bf16_t*)(ws + (which ? WS_VCMP : WS_KCMP)), p.kv_k_gain, which ? 0 : 1}};
            gemm_tile(lds, (const bf16_t*)(ws + WS_HID) + (size_t)which * 8192 * 256, ARowLinear{256}, 64, (const bf16_t*)(ws + WS_W2) + (size_t)which * 128 * 256, 256, tm, 0, epi);
        }
        return;
    }
    if (ph == 10 || ph == 13) { phase_attn_b(p, lds, bid, nblk); return; }
}

constexpr int LDS_TOTAL = 65536 + 1024;
static_assert(LDS_LUT + 4 * LUTW * 4 <= LDS_TOTAL, "lds");

#if MEGA
__global__ void __launch_bounds__(256, 2) mega_kernel(Params p) {
    __shared__ __attribute__((aligned(16))) char lds_raw[LDS_TOTAL];
    LAS char* lds = (LAS char*)lds_raw;
    cg::grid_group grid = cg::this_grid();
    for (int ph = 0; ph < NPHASE; ++ph) {
        run_phase(p, lds, ph, blockIdx.x, gridDim.x);
        if (ph + 1 < NPHASE) grid.sync();
    }
}
#else
template <int PH> __global__ void __launch_bounds__(256, 2) phase_kernel(Params p) {
    __shared__ __attribute__((aligned(16))) char lds_raw[LDS_TOTAL];
    LAS char* lds = (LAS char*)lds_raw;
    run_phase(p, lds, PH, blockIdx.x, gridDim.x);
}
#endif

static void add_job(Params& p, const float* src, bf16_t* dst, const float* gain, int ldsrc, int K, int nsrc0, int ndst0, int ncols) {
    ConvJob& j = p.jobs[p.njobs++];
    j.src = src; j.dst = dst; j.gain = gain; j.ldsrc = ldsrc; j.K = K; j.nsrc0 = nsrc0; j.ndst0 = ndst0; j.ncols = ncols; j.tile0 = p.nconv_tiles;
    p.nconv_tiles += (K / 64) * ((ncols + 63) / 64);
}

extern "C" void kernel_launch(void* const* d_in, const int* in_sizes, int n_in, void* d_out, int out_size, void* d_ws, size_t ws_size, hipStream_t stream) {
    Params p;
    memset(&p, 0, sizeof(p));
    const float** f = (const float**)d_in;
    p.x = f[0]; p.rel_table = f[1]; p.a_norm = f[2]; p.a_w_in = f[3]; p.a_q_gain = f[4]; p.a_k_gain = f[5]; p.a_sink = f[6]; p.a_w_out = f[7];
    p.kv_norm = f[8]; p.kv_w = f[9]; p.kv_k_gain = f[10]; p.cmp_k_pos = f[11]; p.cmp_k_w1 = f[12]; p.cmp_k_w2 = f[13];
    p.cmp_v_pos = f[14]; p.cmp_v_w1 = f[15]; p.cmp_v_w2 = f[16]; p.b_norm = f[17]; p.b_w_in = f[18]; p.b_q_gain = f[19]; p.b_w_out = f[20];
    p.out = (float*)d_out; p.ws = (char*)d_ws;
    char* ws = (char*)d_ws;
    for (int L = 0; L < 2; ++L) {
        add_job(p, p.a_w_in + (size_t)L * D_ * A_IN, (bf16_t*)(ws + WS_WINA) + (size_t)L * A_IN * D_, p.a_norm + L * D_, A_IN, D_, 0, 0, A_IN);
        add_job(p, p.a_w_out + (size_t)L * D_ * D_, (bf16_t*)(ws + WS_WOUTA) + (size_t)L * D_ * D_, nullptr, D_, D_, 0, 0, D_);
        add_job(p, p.b_w_out + (size_t)L * D_ * D_, (bf16_t*)(ws + WS_WOUTB) + (size_t)L * D_ * D_, nullptr, D_, D_, 0, 0, D_);
    }
    add_job(p, p.kv_w, (bf16_t*)(ws + WS_WKVB0), p.kv_norm, KVW, D_, 0, 0, KVW);
    for (int L = 0; L < 2; ++L) {
        bf16_t* dst = (L == 0) ? (bf16_t*)(ws + WS_WKVB0) + (size_t)KVW * D_ : (bf16_t*)(ws + WS_WINB1);
        const float* src = p.b_w_in + (size_t)L * D_ * 4144;
        const float* gn = p.b_norm + L * D_;
        add_job(p, src, dst, gn, 4144, D_, 0, 0, 1024);
        add_job(p, src, dst, gn, 4144, D_, 1072, 1024, 3072);
        add_job(p, src, dst, gn, 4144, D_, 1024, 4096, 48);
        add_job(p, nullptr, dst, nullptr, 4144, D_, 0, 4160, 64);
    }
    add_job(p, p.cmp_k_w1, (bf16_t*)(ws + WS_W1), nullptr, 256, 2048, 0, 0, 256);
    add_job(p, p.cmp_v_w1, (bf16_t*)(ws + WS_W1) + (size_t)256 * 2048, nullptr, 256, 2048, 0, 0, 256);
    add_job(p, p.cmp_k_w2, (bf16_t*)(ws + WS_W2), nullptr, 64, 256, 0, 0, 64);
    add_job(p, nullptr, (bf16_t*)(ws + WS_W2), nullptr, 64, 256, 0, 64, 64);
    add_job(p, p.cmp_v_w2, (bf16_t*)(ws + WS_W2) + (size_t)128 * 256, nullptr, 64, 256, 0, 0, 64);
    add_job(p, nullptr, (bf16_t*)(ws + WS_W2) + (size_t)128 * 256, nullptr, 64, 256, 0, 64, 64);
#if MEGA
    static int grid_blocks = 0;
    if (!grid_blocks) {
        int dev = 0, cus = 0, per_cu = 0;
        (void)hipGetDevice(&dev);
        (void)hipDeviceGetAttribute(&cus, hipDeviceAttributeMultiprocessorCount, dev);
        (void)hipOccupancyMaxActiveBlocksPerMultiprocessor(&per_cu, mega_kernel, 256, 0);
        if (per_cu > 2) per_cu = 2;
        if (per_cu < 1) per_cu = 1;
        grid_blocks = cus * per_cu;
    }
    void* args[] = {&p};
    hipError_t e = hipLaunchCooperativeKernel((void*)mega_kernel, dim3(grid_blocks), dim3(256), args, 0, stream);
    if (e != hipSuccess) fprintf(stderr, "cooperative launch failed: %s (grid %d)\n", hipGetErrorString(e), grid_blocks);
#else
#define LP(n) phase_kernel<n><<<512, 256, 0, stream>>>(p)
    LP(0); LP(1); LP(2); LP(3); LP(4); LP(5); LP(6); LP(7); LP(8); LP(9); LP(10); LP(11); LP(12); LP(13); LP(14);
#endif
}
```

```cpp
#include <hip/hip_runtime.h>
#include <hip/hip_cooperative_groups.h>
#include <cstdio>
#include <cstdint>
#include <cstring>
namespace cg = cooperative_groups;
#ifndef PROBE_MODE
#define PROBE_MODE 0
#endif

#define LAS __attribute__((address_space(3)))
typedef unsigned short bf16_t;
typedef short bf16x8 __attribute__((ext_vector_type(8)));
typedef short s16x4 __attribute__((ext_vector_type(4)));
typedef float f32x4 __attribute__((ext_vector_type(4)));
typedef float f32x2 __attribute__((ext_vector_type(2)));
typedef unsigned u32x4 __attribute__((ext_vector_type(4)));
typedef unsigned u32x2 __attribute__((ext_vector_type(2)));
typedef __bf16 bf16x2_t __attribute__((ext_vector_type(2)));
typedef _Float16 h16x2 __attribute__((ext_vector_type(2)));
typedef _Float16 h16x8 __attribute__((ext_vector_type(8)));

constexpr int NTHR = 512;
constexpr int T_ = 32768, S_ = 2048, NB_ = 16, D_ = 1024;
constexpr int A_IN = 2560, B_INP = 4352  , KVW = 1536, KVB_N = KVW + 4096  ;
constexpr float EPS = 1e-6f;
constexpr float LOG2E = 1.4426950408889634f;
constexpr float C1 = 0.125f * LOG2E;
constexpr float NEGBIG = -1e30f;
constexpr int LUTW = 320;

constexpr size_t MiB = 1u << 20;
constexpr size_t WS_LUT = 1 * MiB;
constexpr size_t WS_CB = WS_LUT + 65536;
constexpr size_t WS_PART = 2 * MiB;
constexpr size_t WS_GATES = 4 * MiB;
constexpr size_t WS_WINA = 10 * MiB;
constexpr size_t WS_WOUTA = 20 * MiB;
constexpr size_t WS_WKVB0 = 24 * MiB;
constexpr size_t WS_WINB1 = 36 * MiB;
constexpr size_t WS_WOUTB = 45 * MiB;
constexpr size_t WS_W1 = 49 * MiB;
constexpr size_t WS_W2 = 51 * MiB;
constexpr size_t WS_WG0 = 51 * MiB + 524288;
constexpr size_t WS_XB = 52 * MiB;
constexpr size_t WS_KV = 116 * MiB;
constexpr size_t WS_Q = 212 * MiB;
constexpr size_t WS_Z = 276 * MiB;
constexpr size_t WS_HID = 468 * MiB;
constexpr size_t WS_KCMP = 476 * MiB;
constexpr size_t WS_VCMP = 477 * MiB;

struct ConvJob { const float* src; bf16_t* dst; const float* gain; int ldsrc, K, nsrc0, ndst0, ncols, tile0, f16, pad; };
constexpr int MAXJOBS = 32;

struct Params {
    const float *x, *rel_table, *a_norm, *a_w_in, *a_q_gain, *a_k_gain, *a_sink, *a_w_out;
    const float *kv_norm, *kv_w, *kv_k_gain, *cmp_k_pos, *cmp_k_w1, *cmp_k_w2, *cmp_v_pos, *cmp_v_w1, *cmp_v_w2;
    const float *b_norm, *b_w_in, *b_q_gain, *b_w_out;
    float* out;
    char* ws;
    ConvJob jobs[MAXJOBS];
    int njobs, nconv_tiles;
};

__device__ __forceinline__ unsigned pack2(float a, float b) { f32x2 v = {a, b}; bf16x2_t r = __builtin_convertvector(v, bf16x2_t); return __builtin_bit_cast(unsigned, r); }
__device__ __forceinline__ unsigned pack2h(float a, float b) { f32x2 v = {a, b}; h16x2 r = __builtin_convertvector(v, h16x2); return __builtin_bit_cast(unsigned, r); }
__device__ __forceinline__ f32x2 unpack2h(unsigned u) { return __builtin_convertvector(__builtin_bit_cast(h16x2, u), f32x2); }
__device__ __forceinline__ float bflo(unsigned u) { return __uint_as_float(u << 16); }
__device__ __forceinline__ float bfhi(unsigned u) { return __uint_as_float(u & 0xffff0000u); }
__device__ __forceinline__ float fast_exp2(float x) { return __builtin_amdgcn_exp2f(x); }
__device__ __forceinline__ float fast_rcp(float x) { return __builtin_amdgcn_rcpf(x); }
__device__ __forceinline__ float silu_f(float v) { return v * fast_rcp(1.0f + fast_exp2(-v * LOG2E)); }
__device__ __forceinline__ float sigmoid_f(float v) { return fast_rcp(1.0f + fast_exp2(-v * LOG2E)); }
__device__ __forceinline__ f32x4 mfma16(bf16x8 a, bf16x8 b, f32x4 c) { return __builtin_amdgcn_mfma_f32_16x16x32_bf16(a, b, c, 0, 0, 0); }
__device__ __forceinline__ int opaque_tid() { int t = threadIdx.x; asm volatile("" : "+v"(t)); return t; }

__host__ __device__ __forceinline__ int wperm(int c) { return 128 * ((c >> 5) & 1) + 32 * ((c >> 6) & 3) + 16 * ((c >> 2) & 1) + 4 * ((c >> 3) & 3) + (c & 3); }

constexpr int LDS_K = 0, LDS_V = 16384, LDS_LUT = 32768;
constexpr int LDS_GST = 106496;
constexpr int LDS_TB = 40960;

struct ConvRegs { f32x4 v[2]; float gn[2]; };
__device__ __forceinline__ void conv_load(const Params& p, int u, int tid, ConvRegs& R) {
    int j = 0;
    while (j + 1 < p.njobs && p.jobs[j + 1].tile0 <= u) ++j;
    const ConvJob& J = p.jobs[j];
    const int lt = u - J.tile0, ktiles = J.K >> 6, nt = lt / ktiles, kt = lt - nt * ktiles, k0 = kt * 64, n0 = nt * 64;
#pragma unroll
    for (int i = 0; i < 2; ++i) {
        const int c = tid + NTHR * i, kk = c >> 4, n4 = (c & 15) * 4;
        R.v[i] = (f32x4){0.f, 0.f, 0.f, 0.f};
        if (J.src && n0 + n4 < J.ncols) R.v[i] = *(const f32x4*)(J.src + (size_t)(k0 + kk) * J.ldsrc + J.nsrc0 + n0 + n4);
        R.gn[i] = J.gain ? J.gain[k0 + kk] : 1.0f;
    }
}
__device__ __forceinline__ void conv_finish(const Params& p, LAS char* lds, int u, int tid, const ConvRegs& R) {
    int j = 0;
    while (j + 1 < p.njobs && p.jobs[j + 1].tile0 <= u) ++j;
    const ConvJob& J = p.jobs[j];
    const int lt = u - J.tile0, ktiles = J.K >> 6, nt = lt / ktiles, kt = lt - nt * ktiles, k0 = kt * 64, n0 = nt * 64;
    LAS float* sm = (LAS float*)lds;
    __syncthreads();
#pragma unroll
    for (int i = 0; i < 2; ++i) {
        const int c = tid + NTHR * i, kk = c >> 4, n4 = (c & 15) * 4;
        sm[kk * 65 + n4 + 0] = R.v[i][0] * R.gn[i]; sm[kk * 65 + n4 + 1] = R.v[i][1] * R.gn[i]; sm[kk * 65 + n4 + 2] = R.v[i][2] * R.gn[i]; sm[kk * 65 + n4 + 3] = R.v[i][3] * R.gn[i];
    }
    __syncthreads();
    {
        const int nn = tid >> 3, k8 = (tid & 7) * 8;
        u32x4 w;
        if (J.f16) {
            w[0] = pack2h(sm[(k8 + 0) * 65 + nn], sm[(k8 + 1) * 65 + nn]);
            w[1] = pack2h(sm[(k8 + 2) * 65 + nn], sm[(k8 + 3) * 65 + nn]);
            w[2] = pack2h(sm[(k8 + 4) * 65 + nn], sm[(k8 + 5) * 65 + nn]);
            w[3] = pack2h(sm[(k8 + 6) * 65 + nn], sm[(k8 + 7) * 65 + nn]);
        } else {
            w[0] = pack2(sm[(k8 + 0) * 65 + nn], sm[(k8 + 1) * 65 + nn]);
            w[1] = pack2(sm[(k8 + 2) * 65 + nn], sm[(k8 + 3) * 65 + nn]);
            w[2] = pack2(sm[(k8 + 4) * 65 + nn], sm[(k8 + 5) * 65 + nn]);
            w[3] = pack2(sm[(k8 + 6) * 65 + nn], sm[(k8 + 7) * 65 + nn]);
        }
        const int L = J.ndst0 + n0 + nn;
        const int prow = (L & ~255) + wperm(L & 255);
        *(u32x4*)(J.dst + (size_t)prow * J.K + k0 + k8) = w;
    }
}

__device__ __forceinline__ void phase_prep(const Params& p, LAS char* lds, int bid, int nblk) {
    const int tid = opaque_tid(), lane = tid & 63, wid = tid >> 6;
    const int nconv = p.nconv_tiles;
    if (bid < 32) {
        const int which = bid >> 4, ng = bid & 15;
        const float* pos = which ? p.cmp_v_pos : p.cmp_k_pos;
        const float* w1 = which ? p.cmp_v_w1 : p.cmp_k_w1;
        const int nn = tid & 15, ks = tid >> 4;
        const int n = ng * 16 + nn;
        float a0 = 0.f, a1 = 0.f, a2 = 0.f, a3 = 0.f;
#pragma unroll 4
        for (int k = ks * 64; k < ks * 64 + 64; k += 4) {
            a0 += pos[k] * w1[(size_t)k * 256 + n]; a1 += pos[k + 1] * w1[(size_t)(k + 1) * 256 + n];
            a2 += pos[k + 2] * w1[(size_t)(k + 2) * 256 + n]; a3 += pos[k + 3] * w1[(size_t)(k + 3) * 256 + n];
        }
        LAS float* sm = (LAS float*)lds;
        sm[ks * 16 + nn] = (a0 + a1) + (a2 + a3);
        __syncthreads();
        if (tid < 16) {
            float s = 0.f;
            for (int q = 0; q < 32; ++q) s += sm[q * 16 + tid];
            ((float*)(p.ws + WS_CB))[which * 256 + ng * 16 + tid] = s;
        }
    }
    for (int u = bid; u < 20; u += nblk) {
        const int i = u * NTHR + tid;
        const int variant = i / (16 * LUTW), rem = i - variant * 16 * LUTW, h = rem / LUTW, k = rem - h * LUTW;
        const int d = 255 - k;
        float v = NEGBIG;
        if (d >= 0 && (variant == 1 || d < 128)) {
            int bk;
            if (d < 16) bk = d;
            else { const int dc = d > 127 ? 127 : d; bk = 16 + (int)(logf((float)dc * (1.0f / 16.0f)) / logf(8.0f) * 16.0f); if (bk > 31) bk = 31; }
            v = p.rel_table[bk * 16 + h] * LOG2E;
            if (variant == 1) v -= p.rel_table[31 * 16 + h] * LOG2E;
        }
        ((float*)(p.ws + WS_LUT))[i] = v;
    }
    {
        ConvRegs Ra, Rb;
        int u = bid;
        if (u < nconv) conv_load(p, u, tid, Ra);
        while (u < nconv) {
            const int un = u + nblk;
            if (un < nconv) conv_load(p, un, tid, Rb);
            conv_finish(p, lds, u, tid, Ra);
            u = un;
            if (u >= nconv) break;
            const int un2 = u + nblk;
            if (un2 < nconv) conv_load(p, un2, tid, Ra);
            conv_finish(p, lds, u, tid, Rb);
            u = un2;
        }
    }
    for (int r0 = bid * 16 + wid * 2; r0 < T_; r0 += nblk * 16) {
        f32x4 v[2][4];
#pragma unroll
        for (int rr = 0; rr < 2; ++rr)
#pragma unroll
            for (int i = 0; i < 4; ++i) v[rr][i] = *(const f32x4*)(p.x + (size_t)(r0 + rr) * D_ + i * 256 + lane * 4);
#pragma unroll
        for (int rr = 0; rr < 2; ++rr) {
            bf16_t* xb = (bf16_t*)(p.ws + WS_XB) + (size_t)(r0 + rr) * D_;
            float ss = 0.f;
#pragma unroll
            for (int i = 0; i < 4; ++i) {
                ss += v[rr][i][0] * v[rr][i][0] + v[rr][i][1] * v[rr][i][1] + v[rr][i][2] * v[rr][i][2] + v[rr][i][3] * v[rr][i][3];
                u32x2 w; w[0] = pack2h(v[rr][i][0], v[rr][i][1]); w[1] = pack2h(v[rr][i][2], v[rr][i][3]);
                *(u32x2*)(xb + i * 256 + lane * 4) = w;
            }
#pragma unroll
            for (int o = 32; o >= 1; o >>= 1) ss += __shfl_xor(ss, o);
            if (lane == 0) ((float*)(p.ws + WS_PART))[r0 + rr] = ss;
        }
    }
    for (int i = bid * NTHR + tid; i < 15 * T_ / 4; i += nblk * NTHR) ((f32x4*)(p.ws + WS_PART) + T_ / 4)[i] = (f32x4){0.f, 0.f, 0.f, 0.f};
}

namespace pg8 {
#define PG8_LAS __attribute__((address_space(3)))
constexpr int BM = 256, BK = 64, HALF = 128, HTB = HALF * BK * 2  , STAGE_BYTES = 8 * HTB, NXCD = 8, WGM = 8;
constexpr int PART_OFF = STAGE_BYTES + 256, GAIN_OFF = PART_OFF + 16384;
__host__ __device__ __forceinline__ int lds_byte(int r, int c) { const int st = (r >> 4) * 2 + (c >> 5), rr = r & 15, cc = c & 31, ob = rr * 64 + cc * 2; return st * 1024 + (ob ^ (((ob >> 9) & 1) << 5)); }
__host__ __device__ __forceinline__ void stage_rc(int b, int& R, int& C) { const int st = b / 1024, sb = b % 1024, swz = sb ^ (((sb >> 9) & 1) << 5); R = (st >> 1) * 16 + swz / 64; C = (st & 1) * 32 + (swz % 64) / 2; }
__host__ __device__ __forceinline__ int perm32(int rho) { const int n = rho >> 4, i = rho & 15; return 8 * (i >> 2) + 4 * n + (i & 3); }
struct Unit { int pm, pn; };
struct Gemm { const bf16_t* A; const bf16_t* Bt; int M, N, K; };
struct StaticOrder {
    int nM, nN, nwg, G, c;
    __host__ __device__ void init(int M, int N, int G_, int c_) { nM = M / BM; nN = N / BM; nwg = nM * nN; G = G_; c = c_; }
    __host__ __device__ bool next(int i, Unit& u) const {
        const long L = (long)i * G + c; if (L >= nwg) return false;
        int wgid = (int)L; { const int q = nwg / NXCD, r = nwg % NXCD, xcd = wgid % NXCD, off = wgid / NXCD; wgid = (xcd < r ? xcd * (q + 1) : r * (q + 1) + (xcd - r) * q) + off; }
        const int nig = WGM * nN, gid = wgid / nig, fm = gid * WGM, gsz = (nM - fm) < WGM ? (nM - fm) : WGM;
        u.pm = fm + ((wgid % nig) % gsz); u.pn = (wgid % nig) / gsz; return true;
    }
    __device__ __forceinline__ void a_ready(const Unit&) const {}
    __device__ __forceinline__ void done(const Unit&) const {}
};
struct ALinear { int lda;
    __device__ __forceinline__ size_t base(int pm) const { return (size_t)pm * 256 * lda * 2; }
    __device__ __forceinline__ size_t hstep() const { return (size_t)128 * lda * 2; }
    __device__ __forceinline__ size_t kstep() const { return 128; }
    __device__ __forceinline__ int rowstride() const { return lda; } };
struct ACmp { int colbase;
    __device__ __forceinline__ size_t base(int pm) const { const int bh = 2 * pm; return ((size_t)(bh >> 2) * S_ * KVW + colbase + (bh & 3) * 64) * 2; }
    __device__ __forceinline__ size_t hstep() const { return 128; }
    __device__ __forceinline__ size_t kstep() const { return (size_t)KVW * 2; }
    __device__ __forceinline__ int rowstride() const { return 16 * KVW; } };

template <bool F16> __device__ __forceinline__ f32x4 mma16(bf16x8 b, bf16x8 a, f32x4 c) {
    if constexpr (F16) return __builtin_amdgcn_mfma_f32_16x16x32_f16(__builtin_bit_cast(h16x8, b), __builtin_bit_cast(h16x8, a), c, 0, 0, 0);
    else return __builtin_amdgcn_mfma_f32_16x16x32_bf16(b, a, c, 0, 0, 0);
}
template <class Epi, class Sched, class AFn, bool ALIGN_EPI = false, bool SP2 = false, bool F16 = false>
__device__ __forceinline__ void gemm_phase(PG8_LAS unsigned char* lds, const Gemm g, const Sched& S, const Epi& E, const AFn& AF) {
    const int tid = ::opaque_tid(), wid = __builtin_amdgcn_readfirstlane(tid >> 6), lane = tid & 63, wr = wid >> 2, wc = wid & 3, fr = lane & 15, fq = lane >> 4;
    const int K = g.K, nt = K / BK;
    unsigned voffA[2], voffB[2];
#pragma unroll
    for (int i = 0; i < 2; ++i) { int R, C; stage_rc(tid * 16 + i * 8192, R, C); const int Rb = Epi::PERM ? ((R & ~31) + perm32(R & 31)) : R;
        voffA[i] = (unsigned)(R * AF.rowstride() + C) * 2u; voffB[i] = (unsigned)(Rb * K + C) * 2u; }
    const size_t kstepB = (size_t)(BK * 2), kstepA = AF.kstep();
    const size_t hstepB = (size_t)HALF * K * 2, hstepA = AF.hstep();
    const size_t tstepB = 2 * hstepB;
    const unsigned ldsw = (unsigned)wid * 1024u;
    const int aoff = lds_byte(wr * 64 + fr, fq * 8), boff = lds_byte(wc * 32 + fr, fq * 8);
#define PG8_SA(b, h) (((b) * 2 + (h)) * HTB)
#define PG8_SB(b, h) ((4 + (b) * 2 + (h)) * HTB)
#define PG8_STAGE(bufoff, gbase, voff) do { _Pragma("unroll") for (int _i = 0; _i < 2; ++_i) \
        __builtin_amdgcn_global_load_lds((const unsigned*)((const char*)(gbase) + (voff)[_i]), (PG8_LAS unsigned*)(lds + (bufoff) + ldsw + _i * 8192), 16, 0, 0); } while (0)
#define PG8_LDA(dst, b, h) do { _Pragma("unroll") for (int m = 0; m < 4; ++m) _Pragma("unroll") for (int k = 0; k < 2; ++k) dst[m][k] = *(const PG8_LAS bf16x8*)(lds + PG8_SA(b, h) + aoff + m * 2048 + k * 1024); } while (0)
#define PG8_LDB(dst, b, h) do { _Pragma("unroll") for (int n = 0; n < 2; ++n) _Pragma("unroll") for (int k = 0; k < 2; ++k) dst[n][k] = *(const PG8_LAS bf16x8*)(lds + PG8_SB(b, h) + boff + n * 2048 + k * 1024); } while (0)
#define PG8_MMA(ai, bj, At, Bt) do { __builtin_amdgcn_s_setprio(1); _Pragma("unroll") for (int m = 0; m < 4; ++m) _Pragma("unroll") for (int n = 0; n < 2; ++n) _Pragma("unroll") for (int k = 0; k < 2; ++k) \
        acc[ai][bj][m][n] = mma16<F16>(Bt[n][k], At[m][k], acc[ai][bj][m][n]); __builtin_amdgcn_s_setprio(0); } while (0)
#define PG8_WAIT_V(n) asm volatile("s_waitcnt vmcnt(" #n ")" ::: "memory")
#define PG8_WAIT_L(n) asm volatile("s_waitcnt lgkmcnt(" #n ")" ::: "memory")
#define PG8_BAR __builtin_amdgcn_s_barrier()
#define PG8_SCHED __builtin_amdgcn_sched_barrier(0)
    Unit cur, nxt; int ui = 0;
    if (!S.next(0, cur)) return;
    if constexpr (Epi::LDSAUX) E.fill_gains(lds, tid);
    int pend = 0;
    f32x4 acc[2][2][4][2];
#pragma unroll
    for (int a = 0; a < 2; ++a)
#pragma unroll
        for (int b = 0; b < 2; ++b)
#pragma unroll
            for (int m = 0; m < 4; ++m)
#pragma unroll
                for (int n = 0; n < 2; ++n) acc[a][b][m][n] = (f32x4){0.f, 0.f, 0.f, 0.f};
    bf16x8 At[4][2], B0[2][2], B1[2][2];
    const char* cA = (const char*)g.A + AF.base(cur.pm); const char* cB = (const char*)g.Bt + (size_t)cur.pn * tstepB;
    S.a_ready(cur);
    if constexpr (SP2) {
        PG8_STAGE(PG8_SB(0, 0), cB, voffB); PG8_STAGE(PG8_SB(0, 1), cB + hstepB, voffB); PG8_STAGE(PG8_SA(0, 0), cA, voffA); PG8_STAGE(PG8_SA(0, 1), cA + hstepA, voffA);
        if (wr == 1) PG8_BAR;
        PG8_WAIT_V(2); PG8_BAR;
        PG8_STAGE(PG8_SB(1, 0), cB + kstepB, voffB); PG8_STAGE(PG8_SA(1, 0), cA + kstepA, voffA); PG8_STAGE(PG8_SB(1, 1), cB + hstepB + kstepB, voffB);
        PG8_WAIT_V(6); PG8_BAR;
    } else {
        PG8_STAGE(PG8_SB(0, 0), cB, voffB); PG8_STAGE(PG8_SA(0, 0), cA, voffA); PG8_STAGE(PG8_SB(0, 1), cB + hstepB, voffB); PG8_STAGE(PG8_SA(0, 1), cA + hstepA, voffA);
        if (wr == 1) PG8_BAR;
        PG8_WAIT_V(4); PG8_BAR;
        PG8_STAGE(PG8_SB(1, 0), cB + kstepB, voffB); PG8_STAGE(PG8_SA(1, 0), cA + kstepA, voffA); PG8_STAGE(PG8_SB(1, 1), cB + hstepB + kstepB, voffB);
        PG8_WAIT_V(6); PG8_BAR;
    }
    for (;;) {
        const bool has_next = S.next(ui + 1, nxt);
        const char* nA = has_next ? (const char*)g.A + AF.base(nxt.pm) : cA; const char* nB = has_next ? (const char*)g.Bt + (size_t)nxt.pn * tstepB : cB;
#pragma unroll 1
        for (int t = 0; t < nt; t += 2) {
            const bool last = (t == nt - 2);
            const char* a1 = cA + (size_t)(t + 1) * kstepA;
            const char* a2 = last ? nA : cA + (size_t)(t + 2) * kstepA; const char* b2 = last ? nB : cB + (size_t)(t + 2) * kstepB;
            const char* a3 = a2 + kstepA; const char* b3 = b2 + kstepB;
            if (last && has_next) S.a_ready(nxt);
            int wm = 0;
            if constexpr (Epi::LDSAUX) { wm = __builtin_amdgcn_readfirstlane((t == 0) ? (pend == 16 ? 2 : 1) : 0); asm volatile("" : "+s"(wm)); }
            if constexpr (SP2) {
            PG8_LDB(B0, 0, 0); PG8_LDB(B1, 0, 1); PG8_SCHED; PG8_LDA(At, 0, 0); PG8_STAGE(PG8_SA(1, 1), a1 + hstepA, voffA);
            if (Epi::LDSAUX && wm == 2) { PG8_WAIT_V(24); } else { PG8_WAIT_V(8); }
            PG8_WAIT_L(0); PG8_BAR; PG8_MMA(0, 0, At, B0); PG8_MMA(0, 1, At, B1); PG8_BAR; PG8_SCHED;
            PG8_LDA(At, 0, 1);
            if (Epi::LDSAUX && wm != 0) {
                const char* pp = (const char*)E.part + ((size_t)wid * T_ + cur.pm * 256) * 4 + (size_t)(::opaque_tid() & 63) * 16;
#pragma unroll
                for (int i = 0; i < 2; ++i) __builtin_amdgcn_global_load_lds((const unsigned*)(pp + (size_t)i * 8 * T_ * 4), (PG8_LAS unsigned*)(lds + PART_OFF + (i * 8 + wid) * 1024), 16, 0, 0);
            }
            PG8_STAGE(PG8_SB(0, 0), b2, voffB); PG8_STAGE(PG8_SB(0, 1), b2 + hstepB, voffB); PG8_STAGE(PG8_SA(0, 0), a2, voffA);
            if (Epi::LDSAUX && wm != 0) { if (wm == 2) { PG8_WAIT_V(26); } else { PG8_WAIT_V(10); } } else { PG8_WAIT_V(8); }
            PG8_WAIT_L(0); PG8_BAR; PG8_MMA(1, 0, At, B0); PG8_MMA(1, 1, At, B1); PG8_BAR; PG8_SCHED;
            PG8_LDB(B0, 1, 0); PG8_LDB(B1, 1, 1); PG8_SCHED; PG8_LDA(At, 1, 0); PG8_STAGE(PG8_SA(0, 1), a2 + hstepA, voffA);
            PG8_WAIT_V(8); PG8_WAIT_L(0); PG8_BAR; PG8_MMA(0, 0, At, B0); PG8_MMA(0, 1, At, B1); PG8_BAR; PG8_SCHED;
            PG8_LDA(At, 1, 1); PG8_STAGE(PG8_SB(1, 0), b3, voffB); PG8_STAGE(PG8_SB(1, 1), b3 + hstepB, voffB); PG8_STAGE(PG8_SA(1, 0), a3, voffA);
            PG8_WAIT_V(8); PG8_WAIT_L(0); PG8_BAR; PG8_MMA(1, 0, At, B0); PG8_MMA(1, 1, At, B1); PG8_BAR; PG8_SCHED;
            } else {
            PG8_LDB(B0, 0, 0); PG8_SCHED; PG8_LDA(At, 0, 0); PG8_STAGE(PG8_SA(1, 1), a1 + hstepA, voffA);
            PG8_WAIT_L(8); PG8_BAR; PG8_WAIT_L(0); PG8_MMA(0, 0, At, B0); PG8_BAR; PG8_SCHED;
            PG8_LDB(B1, 0, 1); PG8_STAGE(PG8_SB(0, 0), b2, voffB);
            PG8_BAR; PG8_WAIT_L(0); PG8_MMA(0, 1, At, B1); PG8_BAR;
            PG8_LDA(At, 0, 1); PG8_STAGE(PG8_SA(0, 0), a2, voffA);
            PG8_BAR; PG8_WAIT_L(0); PG8_MMA(1, 0, At, B0); PG8_BAR; PG8_SCHED;
            PG8_STAGE(PG8_SB(0, 1), b2 + hstepB, voffB);
            PG8_WAIT_V(6); PG8_BAR; PG8_MMA(1, 1, At, B1); PG8_BAR;
            PG8_LDB(B0, 1, 0); PG8_SCHED; PG8_LDA(At, 1, 0); PG8_STAGE(PG8_SA(0, 1), a2 + hstepA, voffA);
            PG8_WAIT_L(8); PG8_BAR; PG8_WAIT_L(0); PG8_MMA(0, 0, At, B0); PG8_BAR; PG8_SCHED;
            PG8_LDB(B1, 1, 1); PG8_STAGE(PG8_SB(1, 0), b3, voffB);
            PG8_BAR; PG8_WAIT_L(0); PG8_MMA(0, 1, At, B1); PG8_BAR;
            PG8_LDA(At, 1, 1); PG8_STAGE(PG8_SA(1, 0), a3, voffA);
            PG8_BAR; PG8_WAIT_L(0); PG8_MMA(1, 0, At, B0); PG8_BAR; PG8_SCHED;
            PG8_STAGE(PG8_SB(1, 1), b3 + hstepB, voffB);
            PG8_WAIT_V(6); PG8_BAR; PG8_MMA(1, 1, At, B1); PG8_BAR;
            }
        }
        if constexpr (ALIGN_EPI) { if (wr == 0) PG8_BAR; }
        if constexpr (!Epi::AFTER_DRAIN) { pend = E(acc, cur, wr, wc, fr, fq, lds); S.done(cur); }
        if (!has_next) break;
#pragma unroll
        for (int a = 0; a < 2; ++a)
#pragma unroll
            for (int b = 0; b < 2; ++b)
#pragma unroll
                for (int m = 0; m < 4; ++m)
#pragma unroll
                    for (int n = 0; n < 2; ++n) acc[a][b][m][n] = (f32x4){0.f, 0.f, 0.f, 0.f};
        cur = nxt; cA = nA; cB = nB; ++ui;
        if constexpr (ALIGN_EPI) { if (wr == 1) PG8_BAR; }
    }
    PG8_WAIT_V(0);
    if constexpr (!ALIGN_EPI) { if (wr == 0) PG8_BAR; }
    PG8_BAR;
    if constexpr (Epi::AFTER_DRAIN) { E.fused(acc, cur, wr, wc, fr, fq, lds, wid, lane); S.done(cur); }
#undef PG8_SA
#undef PG8_SB
#undef PG8_STAGE
#undef PG8_LDA
#undef PG8_LDB
#undef PG8_MMA
#undef PG8_WAIT_V
#undef PG8_WAIT_L
#undef PG8_BAR
#undef PG8_SCHED
}

}

enum { M_PLAIN = 0, M_NORM = 1, M_SIGM = 2, M_SKIP = 3, M_SILUB = 4, M_NORMZ = 5  , M_PLAINZ = 6, M_NORMQ = 7   };
struct GroupInfo { int mode; bf16_t* dst; int ld; const float* aux; float* fdst; int auxidx; };

template <class GroupFn>
struct EpiProj {
    static constexpr bool PERM = false, AFTER_DRAIN = false, LDSAUX = GroupFn::LDSAUX;
    const float* part;
    GroupFn gf;
    __device__ __forceinline__ void fill_gains(PG8_LAS unsigned char* lds, int tid) const {
        if (tid < 256) { const float* gp = gf.gainp(tid >> 6); if (gp) ((PG8_LAS float*)(lds + pg8::GAIN_OFF))[tid] = gp[tid & 63]; }
    }
    template <int MODE>
    __device__ __forceinline__ void body(const f32x4 (&acc)[2][2][4][2], const pg8::Unit& u, int wr, int fr, int fq, const GroupInfo& gi, PG8_LAS unsigned char* lds) const {
        { const int tt = ::opaque_tid(); fr = tt & 15; fq = (tt >> 4) & 3; }
        constexpr bool NRM = (MODE == M_NORM || MODE == M_NORMZ || MODE == M_NORMQ);
        constexpr bool ZR = (MODE == M_NORMZ || MODE == M_PLAINZ);
        f32x4 aux[2][2];
        if (NRM || MODE == M_SILUB) {
            if (LDSAUX) {
                const unsigned ga = (unsigned)(uintptr_t)(lds + pg8::GAIN_OFF) + gi.auxidx * 256 + fq * 32;
                asm volatile("ds_read_b128 %0, %4\n\tds_read_b128 %1, %4 offset:16\n\tds_read_b128 %2, %4 offset:128\n\tds_read_b128 %3, %4 offset:144\n\ts_waitcnt lgkmcnt(0)"
                             : "=&v"(aux[0][0]), "=&v"(aux[0][1]), "=&v"(aux[1][0]), "=&v"(aux[1][1]) : "v"(ga) : "memory");
            } else {
            int fqo = fq; asm volatile("" : "+v"(fqo));
#pragma unroll
            for (int bj = 0; bj < 2; ++bj)
#pragma unroll
                for (int n = 0; n < 2; ++n) aux[bj][n] = *(const f32x4*)(gi.aux + 32 * bj + 8 * fqo + 4 * n);
            }
        }
        const bool odd = fr & 1;
        bf16_t* const rowp0 = (MODE == M_SIGM) ? nullptr : gi.dst + (size_t)(u.pm * 256 + wr * 64 + (fr & ~1)) * gi.ld + 8 * fq + (odd ? 32 : 0);
#pragma unroll
        for (int ai = 0; ai < 2; ++ai) {
            float rs[4] = {1.0f, 1.0f, 1.0f, 1.0f};
            if (LDSAUX) {
                const unsigned pa = (unsigned)(uintptr_t)(lds + pg8::PART_OFF) + (wr * 64 + (fq * 16 + fr)) * 4 + ai * 512;
                float q[16];
                asm volatile("ds_read_b32 %0, %16\n\tds_read_b32 %1, %16 offset:1024\n\tds_read_b32 %2, %16 offset:2048\n\tds_read_b32 %3, %16 offset:3072\n\t"
                             "ds_read_b32 %4, %16 offset:4096\n\tds_read_b32 %5, %16 offset:5120\n\tds_read_b32 %6, %16 offset:6144\n\tds_read_b32 %7, %16 offset:7168\n\t"
                             "ds_read_b32 %8, %16 offset:8192\n\tds_read_b32 %9, %16 offset:9216\n\tds_read_b32 %10, %16 offset:10240\n\tds_read_b32 %11, %16 offset:11264\n\t"
                             "ds_read_b32 %12, %16 offset:12288\n\tds_read_b32 %13, %16 offset:13312\n\tds_read_b32 %14, %16 offset:14336\n\tds_read_b32 %15, %16 offset:15360\n\ts_waitcnt lgkmcnt(0)"
                             : "=&v"(q[0]), "=&v"(q[1]), "=&v"(q[2]), "=&v"(q[3]), "=&v"(q[4]), "=&v"(q[5]), "=&v"(q[6]), "=&v"(q[7]),
                               "=&v"(q[8]), "=&v"(q[9]), "=&v"(q[10]), "=&v"(q[11]), "=&v"(q[12]), "=&v"(q[13]), "=&v"(q[14]), "=&v"(q[15]) : "v"(pa) : "memory");
                const float sl = (((q[0] + q[1]) + (q[2] + q[3])) + ((q[4] + q[5]) + (q[6] + q[7]))) + (((q[8] + q[9]) + (q[10] + q[11])) + ((q[12] + q[13]) + (q[14] + q[15])));
                const float rl = rsqrtf(sl * (1.0f / D_) + EPS);
#pragma unroll
                for (int m = 0; m < 4; ++m) rs[m] = __shfl(rl, m * 16 + fr);
            }
#pragma unroll
            for (int m = 0; m < 4; ++m) {
                const int row = u.pm * 256 + ai * 128 + wr * 64 + m * 16 + fr;
                f32x4 v[2][2];
#pragma unroll
                for (int bj = 0; bj < 2; ++bj)
#pragma unroll
                    for (int n = 0; n < 2; ++n) v[bj][n] = acc[ai][bj][m][n] * rs[m];
                if (NRM) {
                    float ss = 0.f;
#pragma unroll
                    for (int bj = 0; bj < 2; ++bj)
#pragma unroll
                        for (int n = 0; n < 2; ++n) ss += (v[bj][n][0] * v[bj][n][0] + v[bj][n][1] * v[bj][n][1]) + (v[bj][n][2] * v[bj][n][2] + v[bj][n][3] * v[bj][n][3]);
                    ss += __shfl_xor(ss, 16); ss += __shfl_xor(ss, 32);
                    const float inv = rsqrtf(ss * (1.0f / 64.0f) + EPS) * (MODE == M_NORMQ ? C1 : 1.0f);
#pragma unroll
                    for (int bj = 0; bj < 2; ++bj)
#pragma unroll
                        for (int n = 0; n < 2; ++n) v[bj][n] = v[bj][n] * inv * aux[bj][n];
                } else if (MODE == M_SILUB) {
#pragma unroll
                    for (int bj = 0; bj < 2; ++bj)
#pragma unroll
                        for (int n = 0; n < 2; ++n) {
#pragma unroll
                            for (int r = 0; r < 4; ++r) v[bj][n][r] = silu_f(v[bj][n][r] + aux[bj][n][r]); }
                }
                if (ZR) {
                    if ((row & 127) == 127) {
#pragma unroll
                        for (int bj = 0; bj < 2; ++bj)
#pragma unroll
                            for (int n = 0; n < 2; ++n) v[bj][n] = (f32x4){0.f, 0.f, 0.f, 0.f};
                    }
                }
                if (MODE == M_SIGM) {
#pragma unroll
                    for (int bj = 0; bj < 2; ++bj) {
                        if (32 * bj + 8 * fq < 48) {
#pragma unroll
                            for (int n = 0; n < 2; ++n) { f32x4 sg;
#pragma unroll
                                for (int r = 0; r < 4; ++r) sg[r] = sigmoid_f(v[bj][n][r]);
                                *(f32x4*)(gi.fdst + (size_t)row * 48 + 32 * bj + 8 * fq + 4 * n) = sg; }
                        }
                    }
                } else {
                    u32x4 w[2];
#pragma unroll
                    for (int bj = 0; bj < 2; ++bj) { w[bj][0] = pack2(v[bj][0][0], v[bj][0][1]); w[bj][1] = pack2(v[bj][0][2], v[bj][0][3]); w[bj][2] = pack2(v[bj][1][0], v[bj][1][1]); w[bj][3] = pack2(v[bj][1][2], v[bj][1][3]); }
                    u32x4 wa, wb;
#pragma unroll
                    for (int e = 0; e < 4; ++e) {
                        const unsigned give = odd ? w[0][e] : w[1][e];
                        const unsigned recv = (unsigned)__builtin_amdgcn_mov_dpp((int)give, 0xB1, 0xF, 0xF, true);
                        wa[e] = odd ? recv : w[0][e];
                        wb[e] = odd ? w[1][e] : recv;
                    }
                    bf16_t* const rp = rowp0 + (size_t)((ai * 8 + m) * 16) * gi.ld;
                    *(u32x4*)rp = wa;
                    *(u32x4*)(rp + gi.ld) = wb;
                }
            }
        }
    }
    __device__ __forceinline__ int operator()(const f32x4 (&acc)[2][2][4][2], const pg8::Unit& u, int wr, int wc, int fr, int fq, PG8_LAS unsigned char* lds) const {
        const GroupInfo gi = gf(u.pn * 4 + wc);
        constexpr unsigned MM = GroupFn::MODES;
        if ((MM >> M_PLAIN & 1) && gi.mode == M_PLAIN) { body<M_PLAIN>(acc, u, wr, fr, fq, gi, lds); return LDSAUX ? 16 : 0; }
        else if ((MM >> M_NORM & 1) && gi.mode == M_NORM) { body<M_NORM>(acc, u, wr, fr, fq, gi, lds); return LDSAUX ? 16 : 0; }
        else if ((MM >> M_NORMQ & 1) && gi.mode == M_NORMQ) { body<M_NORMQ>(acc, u, wr, fr, fq, gi, lds); return LDSAUX ? 16 : 0; }
        else if ((MM >> M_SIGM & 1) && gi.mode == M_SIGM) body<M_SIGM>(acc, u, wr, fr, fq, gi, lds);
        else if ((MM >> M_SILUB & 1) && gi.mode == M_SILUB) body<M_SILUB>(acc, u, wr, fr, fq, gi, lds);
        else if ((MM >> M_NORMZ & 1) && gi.mode == M_NORMZ) body<M_NORMZ>(acc, u, wr, fr, fq, gi, lds);
        else if ((MM >> M_PLAINZ & 1) && gi.mode == M_PLAINZ) body<M_PLAINZ>(acc, u, wr, fr, fq, gi, lds);
        return 0;
    }
};

template <bool LAST>
struct EpiOut {
    static constexpr bool PERM = false, AFTER_DRAIN = false, LDSAUX = false;
    bf16_t* xh; float* out; float* part;
    static __device__ __forceinline__ unsigned nb(unsigned v) { return (unsigned)__builtin_amdgcn_mov_dpp((int)v, 0xB1, 0xF, 0xF, true); }
    __device__ __forceinline__ int operator()(const f32x4 (&acc)[2][2][4][2], const pg8::Unit& u, int wr, int wc, int fr, int fq, PG8_LAS unsigned char*) const {
        { const int tt = ::opaque_tid(); fr = tt & 15; fq = (tt >> 4) & 3; }
        const bool odd = fr & 1;
        const size_t lane0 = (size_t)(u.pm * 256 + wr * 64 + (fr & ~1)) * D_ + u.pn * 256 + 64 * wc;
        bf16_t* const xp = xh + lane0 + 8 * fq + (odd ? 32 : 0);
#pragma unroll
        for (int ai = 0; ai < 2; ++ai) {
            u32x4 xa[4], xb[4];
            float ssel = 0.f;
#pragma unroll
            for (int m = 0; m < 4; ++m) { xa[m] = *(const u32x4*)(xp + (size_t)(ai * 128 + m * 16) * D_); xb[m] = *(const u32x4*)(xp + (size_t)(ai * 128 + m * 16 + 1) * D_); }
#pragma unroll
            for (int m = 0; m < 4; ++m) {
                u32x4 xo[2];
#pragma unroll
                for (int e = 0; e < 4; ++e) { const unsigned recv = nb(odd ? xa[m][e] : xb[m][e]); xo[0][e] = odd ? recv : xa[m][e]; xo[1][e] = odd ? xb[m][e] : recv; }
                float ss = 0.f;
                f32x4 x0[2], x1[2];
#pragma unroll
                for (int bj = 0; bj < 2; ++bj) {
                    const f32x2 a0 = unpack2h(xo[bj][0]), a1 = unpack2h(xo[bj][1]), a2 = unpack2h(xo[bj][2]), a3 = unpack2h(xo[bj][3]);
                    x0[bj] = (f32x4){a0[0], a0[1], a1[0], a1[1]} + acc[ai][bj][m][0]; x1[bj] = (f32x4){a2[0], a2[1], a3[0], a3[1]} + acc[ai][bj][m][1];
                }
                if (LAST) {
                    float* const op = out + lane0 + (size_t)(ai * 128 + m * 16) * D_ + 8 * fq + (odd ? 4 : 0);
#pragma unroll
                    for (int bj = 0; bj < 2; ++bj) {
                        f32x4 oa, ob;
#pragma unroll
                        for (int e = 0; e < 4; ++e) {
                            const float recv = __builtin_bit_cast(float, nb(__builtin_bit_cast(unsigned, odd ? x0[bj][e] : x1[bj][e])));
                            oa[e] = odd ? recv : x0[bj][e]; ob[e] = odd ? x1[bj][e] : recv;
                        }
                        *(f32x4*)(op + 32 * bj) = oa; *(f32x4*)(op + 32 * bj + D_) = ob;
                    }
                } else {
                    u32x4 w[2];
#pragma unroll
                    for (int bj = 0; bj < 2; ++bj) {
                        w[bj][0] = pack2h(x0[bj][0], x0[bj][1]); w[bj][1] = pack2h(x0[bj][2], x0[bj][3]); w[bj][2] = pack2h(x1[bj][0], x1[bj][1]); w[bj][3] = pack2h(x1[bj][2], x1[bj][3]);
                        ss += ((x0[bj][0] * x0[bj][0] + x0[bj][1] * x0[bj][1]) + (x0[bj][2] * x0[bj][2] + x0[bj][3] * x0[bj][3])) + ((x1[bj][0] * x1[bj][0] + x1[bj][1] * x1[bj][1]) + (x1[bj][2] * x1[bj][2] + x1[bj][3] * x1[bj][3]));
                    }
                    u32x4 wa, wb;
#pragma unroll
                    for (int e = 0; e < 4; ++e) { const unsigned recv = nb(odd ? w[0][e] : w[1][e]); wa[e] = odd ? recv : w[0][e]; wb[e] = odd ? w[1][e] : recv; }
                    *(u32x4*)(xp + (size_t)(ai * 128 + m * 16) * D_) = wa; *(u32x4*)(xp + (size_t)(ai * 128 + m * 16 + 1) * D_) = wb;
                    ss += __shfl_xor(ss, 16); ss += __shfl_xor(ss, 32);
                    if (fq == m) ssel = ss;
                }
            }
            if (!LAST) part[(size_t)(u.pn * 4 + wc) * T_ + u.pm * 256 + ai * 128 + wr * 64 + fq * 16 + fr] = ssel;
            asm volatile("" ::: "memory");
        }
        return 0;
    }
};

struct GfA {
    static constexpr unsigned MODES = 1u << M_PLAIN | 1u << M_NORM | 1u << M_NORMQ;
    static constexpr bool LDSAUX = true;
    bf16_t* proj; const float* qg; const float* kg;
    __device__ __forceinline__ const float* gainp(int j) const { return j == 0 ? qg : (j == 1 ? kg : nullptr); }
    __device__ __forceinline__ GroupInfo operator()(int G) const {
        GroupInfo gi; gi.dst = proj + G * 64; gi.ld = A_IN; gi.fdst = nullptr; gi.aux = nullptr; gi.mode = M_PLAIN; gi.auxidx = 0;
        if (G < 16) { gi.mode = M_NORMQ; gi.aux = qg; } else if (G < 20) { gi.mode = M_NORM; gi.aux = kg; gi.auxidx = 1; }
        return gi;
    }
};
struct GfB {
    static constexpr unsigned MODES = 1u << M_PLAIN | 1u << M_NORM | 1u << M_NORMQ | 1u << M_SIGM;
    static constexpr bool LDSAUX = true;
    __device__ __forceinline__ const float* gainp(int j) const { return j == 0 ? qg : (j == 1 ? kvg + 64 : (j == 2 ? kvg + 128 : nullptr)); }
    int kvgroups; bf16_t* kv; const float* kvg; bf16_t* q; bf16_t* z; float* gates; const float* qg;
    __device__ __forceinline__ GroupInfo operator()(int G) const {
        GroupInfo gi; gi.fdst = nullptr; gi.aux = nullptr; gi.mode = M_PLAIN; gi.dst = nullptr; gi.ld = 0; gi.auxidx = 0;
        if (G < kvgroups) {
            gi.dst = kv + G * 64; gi.ld = KVW;
            const int s = G >> 2;
            if (s == 2) { gi.mode = M_NORM; gi.aux = kvg + 64; gi.auxidx = 1; } else if (s == 4) { gi.mode = M_NORM; gi.aux = kvg + 128; gi.auxidx = 2; }
            return gi;
        }
        const int Gp = G - kvgroups;
        if (Gp < 16) { gi.mode = M_NORMQ; gi.aux = qg; gi.dst = q + Gp * 64; gi.ld = D_; }
        else if (Gp < 64) { gi.dst = z + (Gp - 16) * 64; gi.ld = 3072; }
        else if (Gp == 64) { gi.mode = M_SIGM; gi.fdst = gates; }
        else gi.mode = M_SKIP;
        return gi;
    }
};
struct GfG {
    static constexpr unsigned MODES = 1u << M_SIGM;
    static constexpr bool LDSAUX = true;
    __device__ __forceinline__ const float* gainp(int) const { return nullptr; }
    float* gates;
    __device__ __forceinline__ GroupInfo operator()(int G) const { GroupInfo gi; gi.dst = nullptr; gi.ld = 0; gi.aux = nullptr; gi.fdst = gates; gi.auxidx = 0; gi.mode = (G == 0) ? M_SIGM : M_SKIP; return gi; }
};
struct GfC1 {
    static constexpr unsigned MODES = 1u << M_SILUB;
    static constexpr bool LDSAUX = false;
    bf16_t* hid; const float* cb;
    __device__ __forceinline__ GroupInfo operator()(int G) const { GroupInfo gi; gi.mode = M_SILUB; gi.dst = hid + G * 64; gi.ld = 256; gi.aux = cb + G * 64; gi.fdst = nullptr; gi.auxidx = 0; return gi; }
};
template <int ISK> struct GfC2 {
    static constexpr unsigned MODES = ISK ? 1u << M_NORMZ : 1u << M_PLAINZ;
    static constexpr bool LDSAUX = false;
    bf16_t* dst; const float* gain;
    __device__ __forceinline__ GroupInfo operator()(int G) const { GroupInfo gi; gi.dst = dst; gi.ld = 64; gi.aux = gain; gi.fdst = nullptr; gi.auxidx = 0;
        gi.mode = (G != 0) ? M_SKIP : (ISK ? M_NORMZ : M_PLAINZ); return gi; }
};


__device__ __forceinline__ void glds16(const void* gsrc, unsigned lds_dst) {
    unsigned keep;
    asm volatile("s_mov_b32 %0, m0\n\ts_mov_b32 m0, %2\n\ts_nop 0\n\tglobal_load_lds_dwordx4 %1, off\n\ts_mov_b32 m0, %0" : "=&s"(keep) : "v"(gsrc), "s"(lds_dst) : "memory");
}
__device__ __forceinline__ void dma_rows(int tid, LAS char* dst, const bf16_t* src, size_t ld, int nrows, bool vswz) {
    const int lane = tid & 63, wid = __builtin_amdgcn_readfirstlane(tid >> 6);
    const int r = 8 * wid + (lane >> 3), slot = lane & 7;
    const int chn = vswz ? (slot ^ (((r >> 1) & 3) << 1)) : (slot ^ ((r >> 1) & 7));
    const bf16_t* s0 = src + (size_t)r * ld + chn * 8;
    const unsigned d0 = (unsigned)__builtin_amdgcn_readfirstlane((int)(unsigned)(uintptr_t)(dst + wid * 1024));
    glds16(s0, d0);
    if (nrows == 128) glds16(s0 + 64 * ld, d0 + 8192u);
}
#define DMA_WAIT() asm volatile("s_waitcnt vmcnt(0)" ::: "memory")
constexpr int NRB = 4;

__device__ __forceinline__ bf16x8 read_kfrag(LAS const char* Kb, int rowbase, int kk, int l15, int g) {
    return *(LAS const bf16x8*)(Kb + (rowbase + l15) * 128 + (((kk * 4 + g) ^ (l15 >> 1)) << 4));
}
__device__ __forceinline__ bf16x8 read_vfrag(LAS const char* Vb, int rowbase, int dt, int l15, int g) {
    const int p = l15 & 3;
    const int sw = ((2 * dt + (p >> 1)) ^ (((2 * g + (l15 >> 3)) & 3) << 1)) << 4;
    const int r0 = rowbase + 4 * g + (l15 >> 2);
    LAS const char* a0 = Vb + r0 * 128 + sw + (p & 1) * 8;
    const s16x4 lo = __builtin_bit_cast(s16x4, __builtin_amdgcn_ds_read_tr16_b64_v4i16((LAS s16x4*)a0));
    const s16x4 hi = __builtin_bit_cast(s16x4, __builtin_amdgcn_ds_read_tr16_b64_v4i16((LAS s16x4*)(a0 + 16 * 128)));
    return (bf16x8){lo[0], lo[1], lo[2], lo[3], hi[0], hi[1], hi[2], hi[3]};
}

template <bool NEAR, bool WMASK, bool LOFF>
__device__ __forceinline__ void attend32(LAS const char* Kb, LAS const char* Vb, int rowbase, const bf16x8 (&qf)[4][2], f32x4 (&o)[4][4],
                                         f32x4 (&l)[4], LAS const float* lutp, int dist0, float laneoff, const f32x4& lsplat, int l15, int g) {
    const bf16x8 ones = __builtin_bit_cast(bf16x8, (u32x4){0x3F803F80u, 0x3F803F80u, 0x3F803F80u, 0x3F803F80u});
    bf16x8 kf[2][2];
#pragma unroll
    for (int kt = 0; kt < 2; ++kt)
#pragma unroll
        for (int kk = 0; kk < 2; ++kk) kf[kt][kk] = read_kfrag(Kb, rowbase + 16 * kt, kk, l15, g);
    bf16x8 pf[4];
#pragma unroll
    for (int h = 0; h < 4; ++h) {
        f32x4 sh[2];
#pragma unroll
        for (int kt = 0; kt < 2; ++kt) {
            f32x4 ci;
            if (NEAR) { ci = (f32x4){lutp[h * LUTW + 16 * kt + 0], lutp[h * LUTW + 16 * kt + 1], lutp[h * LUTW + 16 * kt + 2], lutp[h * LUTW + 16 * kt + 3]};
                        if (LOFF) ci = ci + laneoff; }
            else { if (LOFF) ci = lsplat; else ci = (f32x4){0.f, 0.f, 0.f, 0.f}; }
            sh[kt] = mfma16(kf[kt][0], qf[h][0], ci);
            sh[kt] = mfma16(kf[kt][1], qf[h][1], sh[kt]);
        }
        float t[2][4];
#pragma unroll
        for (int kt = 0; kt < 2; ++kt)
#pragma unroll
            for (int r = 0; r < 4; ++r) {
                float tv = sh[kt][r];
                if (WMASK) { const int d = dist0 - 16 * kt - r; tv = (d >= 512) ? NEGBIG : tv; }
                t[kt][r] = fast_exp2(tv);
            }
        u32x4 pw; pw[0] = pack2(t[0][0], t[0][1]); pw[1] = pack2(t[0][2], t[0][3]); pw[2] = pack2(t[1][0], t[1][1]); pw[3] = pack2(t[1][2], t[1][3]);
        pf[h] = __builtin_bit_cast(bf16x8, pw);
        l[h] = mfma16(ones, pf[h], l[h]);
    }
#pragma unroll
    for (int dt = 0; dt < 4; ++dt) {
        const bf16x8 vf = read_vfrag(Vb, rowbase, dt, l15, g);
#pragma unroll
        for (int h = 0; h < 4; ++h) o[h][dt] = mfma16(vf, pf[h], o[h][dt]);
    }
}

__device__ __forceinline__ void load_qfrags(bf16x8 (&qf)[4][2], const bf16_t* qrow  , int g) {
#pragma unroll
    for (int h = 0; h < 4; ++h)
#pragma unroll
        for (int kk = 0; kk < 2; ++kk) qf[h][kk] = *(const bf16x8*)(qrow + h * 64 + kk * 32 + 8 * g);
#pragma unroll
    for (int h = 0; h < 4; ++h)
#pragma unroll
        for (int kk = 0; kk < 2; ++kk) asm volatile("" : "+v"(qf[h][kk]));
}

__device__ __forceinline__ void build_lut(int tid, LAS char* lds, const float* lutg, int kvh, int variant) {
    const float* src = lutg + (size_t)(variant * 4 + kvh) * (4 * LUTW) + tid;
    LAS float* dst = (LAS float*)(lds + LDS_LUT) + tid;
    dst[0] = src[0]; dst[512] = src[512];
    if (tid < 4 * LUTW - 1024) dst[1024] = src[1024];
}

struct RowT { u32x4 v[2]; };
__device__ __forceinline__ RowT rowt_load(const bf16_t* base  , size_t ld, int lane) {
    RowT r; const int rr = lane >> 3, cc = lane & 7;
    r.v[0] = *(const u32x4*)(base + (size_t)rr * ld + cc * 8); r.v[1] = *(const u32x4*)(base + (size_t)(rr + 8) * ld + cc * 8);
    return r;
}
__device__ __forceinline__ void rowt_store(bf16_t* base, size_t ld, int lane, const RowT& r) {
    const int rr = lane >> 3, cc = lane & 7;
    *(u32x4*)(base + (size_t)rr * ld + cc * 8) = r.v[0]; *(u32x4*)(base + (size_t)(rr + 8) * ld + cc * 8) = r.v[1];
}
__device__ __forceinline__ void rowt_to_lds(LAS char* stg, int lane, const RowT& r) {
    const int rr = lane >> 3, cc = lane & 7;
    *(LAS u32x4*)(stg + rr * 144 + cc * 16) = r.v[0]; *(LAS u32x4*)(stg + (rr + 8) * 144 + cc * 16) = r.v[1];
}
__device__ __forceinline__ RowT rowt_from_lds(LAS const char* stg, int lane) {
    RowT r; const int rr = lane >> 3, cc = lane & 7;
    r.v[0] = *(LAS const u32x4*)(stg + rr * 144 + cc * 16); r.v[1] = *(LAS const u32x4*)(stg + (rr + 8) * 144 + cc * 16);
    return r;
}
template <bool HASPREV>
__device__ __forceinline__ RowT gate_head(LAS char* stg, const f32x4 (&o)[4], float gs, const RowT& z, const RowT& prev, int lane, int l15, int g) {
    u32x2 zz[4], pv[4];
    rowt_to_lds(stg, lane, z);
#pragma unroll
    for (int dt = 0; dt < 4; ++dt) zz[dt] = *(LAS const u32x2*)(stg + l15 * 144 + 32 * dt + 8 * g);
    if (HASPREV) {
        rowt_to_lds(stg, lane, prev);
#pragma unroll
        for (int dt = 0; dt < 4; ++dt) pv[dt] = *(LAS const u32x2*)(stg + l15 * 144 + 32 * dt + 8 * g);
    }
#pragma unroll
    for (int dt = 0; dt < 4; ++dt) {
        float v0 = o[dt][0] * gs * silu_f(bflo(zz[dt][0])), v1 = o[dt][1] * gs * silu_f(bfhi(zz[dt][0]));
        float v2 = o[dt][2] * gs * silu_f(bflo(zz[dt][1])), v3 = o[dt][3] * gs * silu_f(bfhi(zz[dt][1]));
        if (HASPREV) { v0 += bflo(pv[dt][0]); v1 += bfhi(pv[dt][0]); v2 += bflo(pv[dt][1]); v3 += bfhi(pv[dt][1]); }
        u32x2 wv; wv[0] = pack2(v0, v1); wv[1] = pack2(v2, v3);
        *(LAS u32x2*)(stg + l15 * 144 + 32 * dt + 8 * g) = wv;
    }
    return rowt_from_lds(stg, lane);
}
__device__ __forceinline__ void gate_branch4(LAS char* stg, bf16_t* ow  , size_t old_, const f32x4 (&o)[4][4], const f32x4 (&l)[4], const float* gbr  ,
                                             const bf16_t* zw  , int lane, int l15, int g) {
    RowT zq[4], pq[4]; float gv[4];
#pragma unroll
    for (int h = 0; h < 4; ++h) { gv[h] = gbr[h]; zq[h] = rowt_load(zw + h * 64, 3072, lane); pq[h] = rowt_load(ow + h * 64, old_, lane); }
#pragma unroll
    for (int h = 0; h < 4; ++h) {
        const float lt = l[h][0];
        const RowT r = gate_head<true>(stg, o[h], gv[h] / lt, zq[h], pq[h], lane, l15, g);
        rowt_store(ow + h * 64, old_, lane, r);
    }
}

__device__ __forceinline__ int attn_item(int rnd, int bid, int nblk) {
    if (rnd * nblk >= 1024) return -1;
    int it;
    if (nblk == 256) {
        const unsigned tab = (bid >> 6) == 0 ? 0x04CFu   : (bid >> 6) == 1 ? 0x13DEu   : (bid >> 6) == 2 ? 0x27ABu   : 0x5689u  ;
        const int Jt = (int)((tab >> (4 * rnd)) & 15u);
        it = (15 - Jt) * 64 + (bid & 63); }
    else it = rnd * nblk + ((rnd & 1) ? (nblk - 1 - bid) : bid);
    return it < 1024 ? it : -1;
}
__device__ __forceinline__ void attn_a_issue(int tid, LAS char* lds, const bf16_t* proj, int it) {
    const int J = 15 - (it >> 6), bh = it & 63, b = bh >> 2, kvh = bh & 3;
    const int jlo_a = 2 * J - 2 < 0 ? 0 : 2 * J - 2, nst = 2 * J + 2 - jlo_a;
    const bf16_t* kbase = proj + (size_t)b * S_ * A_IN + 1024 + kvh * 64;
#pragma unroll 1
    for (int t0 = 0; t0 < nst; ++t0) {
        dma_rows(tid, lds + LDS_TB + t0 * 16384, kbase + (size_t)(2 * J + 1 - t0) * 64 * A_IN, A_IN, 64, false);
        dma_rows(tid, lds + LDS_TB + t0 * 16384 + 8192, kbase + (size_t)(2 * J + 1 - t0) * 64 * A_IN + 256, A_IN, 64, true);
    }
}

__device__ __forceinline__ void phase_attn_a(const Params& p, LAS char* lds, int bid, int nblk, int layer) {
    const bf16_t* proj = (const bf16_t*)(p.ws + WS_Q);
    bf16_t* O = (bf16_t*)(p.ws + WS_KV);
    const float* lutg = (const float*)(p.ws + WS_LUT);
    LAS const float* lut = (LAS const float*)(lds + LDS_LUT);
    int lut_kvh = -1;
    {
        const int it0 = attn_item(0, bid, nblk);
        __syncthreads();
        if (it0 >= 0) attn_a_issue(opaque_tid(), lds, proj, it0);
    }
    for (int rnd = 0; rnd * nblk < 1024; ++rnd) {
        const int it = attn_item(rnd, bid, nblk);
        if (it < 0) continue;
        const int tid = opaque_tid();
        const int lane = tid & 63, w = tid >> 6, l15 = lane & 15, g = lane >> 4;
        const int J = 15 - (it >> 6), bh = it & 63, b = bh >> 2, kvh = bh & 3;
        const int jq = 2 * J + (w >> 2);
        const int qi = 16 * (w & 3) + l15;
        const size_t tg = (size_t)b * S_ + jq * 64 + qi;
        if (kvh != lut_kvh) { build_lut(tid, lds, lutg, kvh, 0); lut_kvh = kvh; }
        const int jlo_a = 2 * J - 2 < 0 ? 0 : 2 * J - 2;
        const int nst = 2 * J + 2 - jlo_a;
        bf16x8 qf[4][2];
        load_qfrags(qf, proj + tg * A_IN + kvh * 256, g);
        f32x4 o[4][4], l[4];
#pragma unroll
        for (int h = 0; h < 4; ++h) {
            l[h] = (f32x4){0.f, 0.f, 0.f, 0.f};
#pragma unroll
            for (int dt = 0; dt < 4; ++dt) o[h][dt] = (f32x4){0.f, 0.f, 0.f, 0.f};
        }
        DMA_WAIT(); __syncthreads();
        for (int st = 0; st < nst; ++st) {
            const int jk = 2 * J + 1 - st;
            const int dj = jq - jk;
            const int dist0 = dj * 64 + qi - 4 * g;
            LAS const float* lutp = lut + (255 - dist0);
            const f32x4 zsplat = (f32x4){0.f, 0.f, 0.f, 0.f};
            LAS const char* kb = lds + LDS_TB + st * 16384;
            if (dj >= 0 && dj <= 2) {
                const int sub_lo = (dj == 2 && (w & 3) >= 2) ? 1 : 0, sub_hi = (dj == 0 && (w & 3) < 2) ? 1 : 2;
#pragma unroll 1
                for (int sub = sub_lo; sub < sub_hi; ++sub)
                    attend32<true, false, false>(kb + sub * 4096, kb + 8192 + sub * 4096, 0, qf, o, l, lutp + 32 * sub, dist0 - 32 * sub, 0.f, zsplat, l15, g);
            }
        }
        __syncthreads();
        { const int itn = attn_item(rnd + 1, bid, nblk); if (itn >= 0) attn_a_issue(tid, lds, proj, itn); }
        {
            LAS char* stg = lds + LDS_GST + w * 2304;
            const bf16_t* zw = proj + (tg - l15) * A_IN + 1536 + kvh * 256;
            bf16_t* ow = O + (tg - l15) * D_ + kvh * 256;
            RowT zq[4];
#pragma unroll
            for (int h = 0; h < 4; ++h) zq[h] = rowt_load(zw + h * 64, A_IN, lane);
#pragma unroll
            for (int h = 0; h < 4; ++h) {
                const float lt = l[h][0] + fast_exp2(p.a_sink[layer * 16 + kvh * 4 + h] * LOG2E);
                const RowT r = gate_head<false>(stg, o[h], 1.0f / lt, zq[h], zq[h], lane, l15, g);
                rowt_store(ow + h * 64, D_, lane, r);
            }
        }
    }
}

__device__ __forceinline__ void attn_b_issue(int tid, LAS char* lds, const char* ws, int it) {
    const int J = 15 - (it >> 6), bh = it & 63, b = bh >> 2, kvh = bh & 3;
    dma_rows(tid, lds + LDS_K, (const bf16_t*)(ws + WS_KCMP) + (size_t)(b * 4 + kvh) * 128 * 64, 64, 128, false);
    dma_rows(tid, lds + LDS_V, (const bf16_t*)(ws + WS_VCMP) + (size_t)(b * 4 + kvh) * 128 * 64, 64, 128, true);
    const bf16_t* kvb = (const bf16_t*)(ws + WS_KV) + (size_t)b * S_ * KVW + kvh * 64;
#pragma unroll 1
    for (int t0 = 0; t0 < 2; ++t0) {
        const bf16_t* src = kvb + (size_t)(2 * J + 1 - t0) * 64 * KVW + 512;
        dma_rows(tid, lds + LDS_TB + t0 * 16384, src, KVW, 64, false);
        dma_rows(tid, lds + LDS_TB + t0 * 16384 + 8192, src + 256, KVW, 64, true);
    }
}

__device__ __forceinline__ void phase_attn_b(const Params& p, LAS char* lds, int bid, int nblk, bf16_t* obase, int old_, int pmode = 0) {
#define Q ((const bf16_t*)(p.ws + WS_Q))
#define Z ((const bf16_t*)(p.ws + WS_Z))
#define KV ((const bf16_t*)(p.ws + WS_KV))
#define KC ((const bf16_t*)(p.ws + WS_KCMP))
#define VC ((const bf16_t*)(p.ws + WS_VCMP))
#define GT ((const float*)(p.ws + WS_GATES))
#define lutg ((const float*)(p.ws + WS_LUT))
    LAS const float* lut = (LAS const float*)(lds + LDS_LUT);
    int lut_kvh = -1;
    {
        const int it0 = attn_item(0, bid, nblk);
        __syncthreads();
        if (it0 >= 0) attn_b_issue(opaque_tid(), lds, p.ws, it0);
    }
    for (int rnd = 0; rnd * nblk < 1024; ++rnd) {
        const int it = attn_item(rnd, bid, nblk);
        if (it < 0) continue;
        const int tid = opaque_tid();
        const int lane = tid & 63, w = tid >> 6, l15 = lane & 15, g = lane >> 4;
        const int J = 15 - (it >> 6), bh = it & 63, b = bh >> 2, kvh = bh & 3;
        const int jq = 2 * J + (w >> 2);
        const int qi = 16 * (w & 3) + l15;
        const int qpos = jq * 64 + qi;
        const size_t tg = (size_t)b * S_ + qpos;
        if (kvh != lut_kvh) { build_lut(tid, lds, lutg, kvh, 1); lut_kvh = kvh; }
        const bf16_t* kvb = KV + (size_t)b * S_ * KVW + kvh * 64;
        const int n_slc = 2 * J + 2;
        const int jlo_w = 2 * J - 8 < 0 ? 0 : 2 * J - 8;
        const int nst = n_slc + (2 * J + 2 - jlo_w);
#define TILE_SRC(s_) (kvb + (size_t)(2 * J + 1 - ((s_) >= n_slc ? (s_) - n_slc : (s_))) * 64 * KVW + ((s_) >= n_slc ? 1024 : 512))
        const int tgi = (int)tg;
#define TGO_() ({ int t_ = tgi; asm volatile("" : "+v"(t_)); (size_t)t_; })
#define zrow (Z + TGO_() * 3072 + kvh * 256)
#define grow (GT + TGO_() * 48 + kvh * 4)
#define orow (obase + TGO_() * old_ + kvh * 256)
#define qrow (Q + TGO_() * D_ + kvh * 256)
#define zwave (Z + (TGO_() - l15) * 3072 + kvh * 256)
#define owave (obase + (TGO_() - l15) * old_ + kvh * 256)
        LAS char* stg = lds + LDS_GST + w * 2304;
        bf16x8 qf[4][2];
        load_qfrags(qf, qrow, g);
        DMA_WAIT();
        __syncthreads();
        f32x4 psum[8];
#pragma unroll
        for (int kt = 0; kt < 8; ++kt) psum[kt] = (f32x4){0.f, 0.f, 0.f, 0.f};
        const bool rowvalid = qpos >= 31;
        const int nck = ((4 * jq + 2) >> 5) + 1;
#pragma unroll
        for (int h = 0; h < 4; ++h) {
            __builtin_amdgcn_sched_barrier(0);
            const bf16x8 q0 = qf[h][0], q1 = qf[h][1];
            LAS const float* luth = lut + h * LUTW;
            const RowT zq0 = rowt_load(zwave + h * 64, 3072, lane);
            const float gv0 = grow[h];
            f32x4 e[8];
            float ll = 0.f;
#pragma unroll
            for (int ck = 0; ck < 4; ++ck) {
                if (ck < nck) {
#pragma unroll
                    for (int kt = 0; kt < 2; ++kt) {
                        f32x4 sv = mfma16(read_kfrag(lds + LDS_K, 32 * ck + 16 * kt, 0, l15, g), q0, (f32x4){0.f, 0.f, 0.f, 0.f});
                        sv = mfma16(read_kfrag(lds + LDS_K, 32 * ck + 16 * kt, 1, l15, g), q1, sv);
                        const bool farg = (jq * 64 + 16 * (w & 3)) - 31 - 16 * (32 * ck + 16 * kt + 15) >= 128;
                        if (farg) {
#pragma unroll
                            for (int r = 0; r < 4; ++r) { const float ev = fast_exp2(sv[r]); e[2 * ck + kt][r] = ev; ll += ev; }
                        } else {
#pragma unroll
                        for (int r = 0; r < 4; ++r) {
                            int d = qpos - 31 - 16 * (32 * ck + 16 * kt + 4 * g + r);
                            d = d < -1 ? -1 : (d > 255 ? 255 : d);
                            const float ev = fast_exp2(sv[r] + luth[255 - d]);
                            e[2 * ck + kt][r] = ev; ll += ev;
                        }
                        }
                    }
                } else { e[2 * ck] = (f32x4){0.f, 0.f, 0.f, 0.f}; e[2 * ck + 1] = (f32x4){0.f, 0.f, 0.f, 0.f}; }
            }
            ll += __shfl_xor(ll, 16); ll += __shfl_xor(ll, 32);
            const float inv = rowvalid ? 1.0f / ll : 0.0f;
            f32x4 oc[4];
#pragma unroll
            for (int dt = 0; dt < 4; ++dt) oc[dt] = (f32x4){0.f, 0.f, 0.f, 0.f};
#pragma unroll
            for (int ck = 0; ck < 4; ++ck) {
                if (ck < nck) {
                    u32x4 pw; pw[0] = pack2(e[2 * ck][0], e[2 * ck][1]); pw[1] = pack2(e[2 * ck][2], e[2 * ck][3]);
                    pw[2] = pack2(e[2 * ck + 1][0], e[2 * ck + 1][1]); pw[3] = pack2(e[2 * ck + 1][2], e[2 * ck + 1][3]);
                    const bf16x8 pfr = __builtin_bit_cast(bf16x8, pw);
#pragma unroll
                    for (int dt = 0; dt < 4; ++dt) oc[dt] = mfma16(read_vfrag(lds + LDS_V, 32 * ck, dt, l15, g), pfr, oc[dt]);
                }
            }
#pragma unroll
            for (int kt = 0; kt < 8; ++kt) psum[kt] = psum[kt] + e[kt] * inv;
            { const RowT r = gate_head<false>(stg, oc, gv0 * inv, zq0, zq0, lane, l15, g); rowt_store(owave + h * 64, old_, lane, r); }
        }
        unsigned selbits;
        {
            float imp[8];
            const int src = (lane - 16) & 63;
#pragma unroll
            for (int kt = 0; kt < 8; ++kt) {
                const float own = (psum[kt][0] + psum[kt][1]) + (psum[kt][2] + psum[kt][3]);
                const float pa = __shfl(psum[kt][3], src);
                const float pb = (kt > 0) ? __shfl(psum[kt > 0 ? kt - 1 : 0][3], src) : 0.f;
                imp[kt] = own + (g > 0 ? pa : pb);
            }
            if (jq <= 7) {
                selbits = (2u << jq) - 1u;
            } else {
                selbits = 1u | (1u << jq) | (1u << (jq - 1));
                float cand[8];
#pragma unroll
                for (int kt = 0; kt < 8; ++kt) { const int j = 4 * kt + g; cand[kt] = (j >= 1 && j <= jq - 2) ? imp[kt] : -INFINITY; }
                for (int itn = 0; itn < 5; ++itn) {
                    float bv = -INFINITY; int bj = 99;
#pragma unroll
                    for (int kt = 0; kt < 8; ++kt) { if (cand[kt] > bv) { bv = cand[kt]; bj = 4 * kt + g; } }
#pragma unroll
                    for (int x = 16; x <= 32; x <<= 1) {
                        const float ov = __shfl_xor(bv, x); const int oj = __shfl_xor(bj, x);
                        if (ov > bv || (ov == bv && oj < bj)) { bv = ov; bj = oj; }
                    }
                    if (bj < 32) selbits |= 1u << bj;
#pragma unroll
                    for (int kt = 0; kt < 8; ++kt) { if (4 * kt + g == bj) cand[kt] = -INFINITY; }
                }
            }
        }
        f32x4 o[4][4], l[4];
#pragma unroll
        for (int h = 0; h < 4; ++h) { l[h] = (f32x4){0.f, 0.f, 0.f, 0.f};
#pragma unroll
            for (int dt = 0; dt < 4; ++dt) o[h][dt] = (f32x4){0.f, 0.f, 0.f, 0.f}; }
        for (int st = 0; st < nst; ++st) {
            const int br = st >= n_slc ? 1 : 0;
            const int jk = 2 * J + 1 - (br ? st - n_slc : st);
            const int dj = jq - jk;
            if ((st & 1) == 0) {
                if (st > 0) { DMA_WAIT(); asm volatile("s_waitcnt lgkmcnt(0)" ::: "memory"); __builtin_amdgcn_s_barrier(); asm volatile("" ::: "memory"); }
                if (st + 2 < nst) {
#pragma unroll 1
                    for (int t0 = st + 2; t0 < st + 4; ++t0) {
                        LAS char* nb = lds + LDS_TB + (t0 & 3) * 16384;
                        const bf16_t* kn = TILE_SRC(t0);
                        dma_rows(tid, nb, kn, KVW, 64, false);
                        dma_rows(tid, nb + 8192, kn + 256, KVW, 64, true);
                    }
                }
            }
            if (st == n_slc) {
                gate_branch4(stg, owave, old_, o, l, grow + 16, zwave + 1024, lane, l15, g);
#pragma unroll
                for (int h = 0; h < 4; ++h) {
                    l[h] = (f32x4){0.f, 0.f, 0.f, 0.f};
#pragma unroll
                    for (int dt = 0; dt < 4; ++dt) o[h][dt] = (f32x4){0.f, 0.f, 0.f, 0.f};
                }
            }
            const int dist0 = dj * 64 + qi - 4 * g;
            const float loff = (br == 0) ? (((selbits >> jk) & 1u) ? 0.f : NEGBIG) : 0.f;
            const f32x4 lsplat = (f32x4){loff, loff, loff, loff};
            LAS const float* lutp = lut + (255 - dist0);
            LAS const char* kb = lds + LDS_TB + (st & (NRB - 1)) * 16384;
            if (dj >= 0 && (br == 0 || dj <= 8) && pmode != 1) {
                const int sub_lo = (br == 1 && dj == 8 && (w & 3) >= 2) ? 1 : 0, sub_hi = (dj == 0 && (w & 3) < 2) ? 1 : (pmode == 2 ? 4 : 2);
#pragma unroll 1
                for (int sub = sub_lo; sub < sub_hi; ++sub) {
                    LAS const char* Kb = kb + (sub & 1) * 4096; LAS const char* Vb = kb + 8192 + (sub & 1) * 4096;
                    if (dj <= 2) attend32<true, false, true>(Kb, Vb, 0, qf, o, l, lutp + 32 * (sub & 1), dist0 - 32 * (sub & 1), loff, lsplat, l15, g);
                    else if (br == 1 && dj == 8) attend32<false, true, false>(Kb, Vb, 0, qf, o, l, lut, dist0 - 32 * (sub & 1), loff, lsplat, l15, g);
                    else attend32<false, false, true>(Kb, Vb, 0, qf, o, l, lut, dist0 - 32 * (sub & 1), loff, lsplat, l15, g);
                }
            }
        }
        asm volatile("s_waitcnt lgkmcnt(0)" ::: "memory"); __builtin_amdgcn_s_barrier(); asm volatile("" ::: "memory");
        { const int itn = attn_item(rnd + 1, bid, nblk); if (itn >= 0) attn_b_issue(tid, lds, p.ws, itn); }
        gate_branch4(stg, owave, old_, o, l, grow + 32, zwave + 2048, lane, l15, g);
    }
}

#undef TGO_
#undef zwave
#undef owave
#undef TILE_SRC
#undef zrow
#undef grow
#undef orow
#undef qrow
#undef Q
#undef Z
#undef KV
#undef KC
#undef VC
#undef GT
#undef lutg

#define XB_TMO      128
#define XB_XCNT(j)  (256  + 64 * (j))
#define XB_XSUB(j)  (1280 + 64 * (j))
#define XB_XGEN(j)  (2304 + 64 * (j))
#define XB_TOP      3328
#define XB_TOPGEN   3392
#define XCD_BAR_WORDS 3456
#define XB_SPIN_CAP (1u << 18)
__device__ __forceinline__ unsigned xb_ld(unsigned* p)              { return __hip_atomic_load(p, __ATOMIC_RELAXED, __HIP_MEMORY_SCOPE_AGENT); }
__device__ __forceinline__ unsigned xb_add(unsigned* p, unsigned v) { return __hip_atomic_fetch_add(p, v, __ATOMIC_RELAXED, __HIP_MEMORY_SCOPE_AGENT); }
__device__ __forceinline__ unsigned xb_xcc_id() { return (unsigned)__builtin_amdgcn_s_getreg((3 << 11) | 20) & 0xFu; }
#define XB_SPIN(cond, bar) do { unsigned _sp = 0; while (cond) { __builtin_amdgcn_s_sleep(1); \
    if ((++_sp & 255u) == 0u) { if (xb_ld(&(bar)[XB_TMO])) break; if (_sp > XB_SPIN_CAP) { atomicAdd(&(bar)[XB_TMO], 1u); break; } } } } while (0)
struct XcdBarrier { unsigned* bar; unsigned x; volatile LAS unsigned* st; };
__device__ __forceinline__ XcdBarrier xcd_barrier_post(unsigned* bar, volatile LAS unsigned* st) {
    XcdBarrier b; b.bar = bar; b.x = xb_xcc_id(); b.st = st;
    if (threadIdx.x == 0) (void)xb_add(&bar[XB_XCNT(b.x)], 1u);
    return b;
}
__device__ __forceinline__ void xcd_barrier_complete(unsigned* bar, unsigned x, unsigned& nloc, unsigned& nx) {
    const unsigned G = gridDim.x * gridDim.y * gridDim.z;
    unsigned sum, cnt, mine, sp = 0u;
    for (;;) {
        sum = 0u; cnt = 0u; mine = 0u;
#pragma unroll
        for (unsigned j = 0; j < 16; ++j) { const unsigned c = xb_ld(&bar[XB_XCNT(j)]); sum += c; cnt += (c > 0u) ? 1u : 0u; mine = (j == x) ? c : mine; }
        if (sum == G) break;
        __builtin_amdgcn_s_sleep(1);
        if ((++sp & 255u) == 0u) { if (xb_ld(&bar[XB_TMO])) break; if (sp > XB_SPIN_CAP) { atomicAdd(&bar[XB_TMO], 1u); break; } }
    }
    nloc = mine > 0u ? mine : 1u; nx = cnt > 0u ? cnt : 1u;
}
__device__ __forceinline__ void xcd_barrier(const XcdBarrier& b) {
    asm volatile("s_waitcnt vmcnt(0)" ::: "memory");
    __syncthreads();
    if (threadIdx.x == 0) {
        unsigned* bar = b.bar;
        __builtin_amdgcn_s_waitcnt(0);
        unsigned nloc = b.st[0], nx = b.st[1];
        if (nloc == 0u) { xcd_barrier_complete(bar, b.x, nloc, nx); b.st[0] = nloc; b.st[1] = nx; }
        const unsigned old = xb_add(&bar[XB_XSUB(b.x)], 1u);
        const unsigned gen = old / nloc;
        if (old + 1u == (gen + 1u) * nloc) {
            __builtin_amdgcn_fence(__ATOMIC_RELEASE, "agent");
            asm volatile("s_waitcnt vmcnt(0)" ::: "memory");
            const unsigned og = xb_add(&bar[XB_TOP], 1u);
            const unsigned tg = og / nx;
            if (og + 1u == (tg + 1u) * nx) xb_add(&bar[XB_TOPGEN], 1u);
            else XB_SPIN(xb_ld(&bar[XB_TOPGEN]) == tg, bar);
            __builtin_amdgcn_fence(__ATOMIC_ACQUIRE, "agent");
            xb_add(&bar[XB_XGEN(b.x)], 1u);
            asm volatile("s_waitcnt vmcnt(0)" ::: "memory");
        } else {
            XB_SPIN(xb_ld(&bar[XB_XGEN(b.x)]) == gen, bar);
            __builtin_amdgcn_fence(__ATOMIC_ACQUIRE, "agent");
            asm volatile("s_waitcnt vmcnt(0)" ::: "memory");
        }
    }
    __syncthreads();
}

constexpr int LDS_XB = pg8::STAGE_BYTES;
constexpr int LDS_BYTES = pg8::GAIN_OFF + 1024;
constexpr int NPHASE = 15;

template <bool F16, class Epi, class AFn>
__device__ __forceinline__ void run_gemm(LAS char* lds, const bf16_t* A, const bf16_t* Bt, int M, int N, int K, int G, int c, const Epi& E, const AFn& AF) {
    pg8::Gemm g{A, Bt, M, N, K};
    pg8::StaticOrder S; S.init(M, N, G, c);
    pg8::gemm_phase<Epi, pg8::StaticOrder, AFn, true, true, F16>((PG8_LAS unsigned char*)lds, g, S, E, AF);
}

template <int ph> __device__ __forceinline__ void run_phase(const Params& p, LAS char* lds, int bid, int nblk) {
    char* ws = p.ws;
    const float* part = (const float*)(ws + WS_PART);
    if (ph == 0) { phase_prep(p, lds, bid, nblk); return; }
    if (ph == 1 || ph == 4) {
        const int L = (ph == 1) ? 0 : 1;
        EpiProj<GfA> epi{part, GfA{(bf16_t*)(ws + WS_Q), p.a_q_gain + L * 64, p.a_k_gain + L * 64}};
        run_gemm<true>(lds, (const bf16_t*)(ws + WS_XB), (const bf16_t*)(ws + WS_WINA) + (size_t)L * A_IN * D_, T_, A_IN, D_, nblk, bid, epi, pg8::ALinear{D_});
        return;
    }
    if (ph == 2 || ph == 5) { phase_attn_a(p, lds, bid, nblk, ph == 2 ? 0 : 1); return; }
    if (ph == 3 || ph == 6 || ph == 11 || ph == 14) {
        const bf16_t* A; int lda = D_; const bf16_t* Wt;
        if (ph == 3) { A = (const bf16_t*)(ws + WS_KV); Wt = (const bf16_t*)(ws + WS_WOUTA); }
        else if (ph == 6) { A = (const bf16_t*)(ws + WS_KV); Wt = (const bf16_t*)(ws + WS_WOUTA) + (size_t)D_ * D_; }
        else if (ph == 11) { A = (const bf16_t*)(ws + WS_Z); Wt = (const bf16_t*)(ws + WS_WOUTB); lda = 3072; }
        else { A = (const bf16_t*)(ws + WS_Z); Wt = (const bf16_t*)(ws + WS_WOUTB) + (size_t)D_ * D_; lda = 3072; }
        if (ph == 14) { EpiOut<true> epi{(bf16_t*)(ws + WS_XB), p.out, (float*)(ws + WS_PART)}; run_gemm<false>(lds, A, Wt, T_, D_, D_, nblk, bid, epi, pg8::ALinear{lda}); }
        else { EpiOut<false> epi{(bf16_t*)(ws + WS_XB), p.out, (float*)(ws + WS_PART)}; run_gemm<false>(lds, A, Wt, T_, D_, D_, nblk, bid, epi, pg8::ALinear{lda}); }
        return;
    }
    if (ph == 7 || ph == 12) {
        const int kvg = (ph == 7) ? 24 : 0;
        const int L = (ph == 7) ? 0 : 1;
        EpiProj<GfB> epi{part, GfB{kvg, (bf16_t*)(ws + WS_KV), p.kv_k_gain, (bf16_t*)(ws + WS_Q), (bf16_t*)(ws + WS_Z), (float*)(ws + WS_GATES), p.b_q_gain + L * 64}};
        run_gemm<true>(lds, (const bf16_t*)(ws + WS_XB), (const bf16_t*)(ws + (ph == 7 ? WS_WKVB0 : WS_WINB1)), T_, ph == 7 ? KVB_N : B_INP, D_, nblk, bid, epi, pg8::ALinear{D_});
        return;
    }
    if (ph == 8) {
        if (bid >= 64 && nblk > 64) {
            EpiProj<GfG> epg{part, GfG{(float*)(ws + WS_GATES)}};
            run_gemm<true>(lds, (const bf16_t*)(ws + WS_XB), (const bf16_t*)(ws + WS_WG0), T_, 256, D_, nblk - 64, bid - 64, epg, pg8::ALinear{D_});
            return;
        }
        const int which = bid & 1;
        EpiProj<GfC1> epi{nullptr, GfC1{(bf16_t*)(ws + WS_HID) + (size_t)which * 8192 * 256, (const float*)(ws + WS_CB) + which * 256}};
        run_gemm<false>(lds, (const bf16_t*)(ws + WS_KV), (const bf16_t*)(ws + WS_W1) + (size_t)which * 256 * 2048, 8192, 256, 2048, nblk >> 1, bid >> 1, epi, pg8::ACmp{which * 256});
        return;
    }
    if (ph == 9) {
        { EpiProj<GfC2<1>> epi{nullptr, GfC2<1>{(bf16_t*)(ws + WS_KCMP), p.kv_k_gain}};
          run_gemm<false>(lds, (const bf16_t*)(ws + WS_HID), (const bf16_t*)(ws + WS_W2), 8192, 256, 256, nblk, bid, epi, pg8::ALinear{256}); }
        { EpiProj<GfC2<0>> epi{nullptr, GfC2<0>{(bf16_t*)(ws + WS_VCMP), p.kv_k_gain}};
          run_gemm<false>(lds, (const bf16_t*)(ws + WS_HID) + (size_t)8192 * 256, (const bf16_t*)(ws + WS_W2) + (size_t)256 * 256, 8192, 256, 256, nblk, (bid + 128) % nblk, epi, pg8::ALinear{256}); }
        return;
    }
    if (ph == 10 || ph == 13) { phase_attn_b(p, lds, bid, nblk, (bf16_t*)(ws + WS_Z), 3072); return; }
    if (ph == 100) { phase_attn_b(p, lds, bid, nblk, (bf16_t*)p.out, 1024, p.njobs > 0 ? PROBE_MODE : 0); return; }
}

__global__ void __launch_bounds__(NTHR, 2) mega_kernel(Params p) {
    extern __shared__ __attribute__((aligned(16))) unsigned char lds_dyn[];
    LAS char* lds = (LAS char*)lds_dyn;
    cg::grid_group grid = cg::this_grid();
    if (p.njobs < 0) grid.sync();
    volatile LAS unsigned* xst = (volatile LAS unsigned*)(lds + LDS_XB);
    if (threadIdx.x < 4) xst[threadIdx.x] = 0u;
    __syncthreads();
    (void)xcd_barrier_post((unsigned*)p.ws, xst);
#define PH_(n) run_phase<n>(p, lds, blockIdx.x, gridDim.x)
#define SYNC_() do { XcdBarrier xb_; xb_.bar = (unsigned*)p.ws; xb_.x = xb_xcc_id(); xb_.st = (volatile LAS unsigned*)(lds + LDS_XB); xcd_barrier(xb_); } while (0)
#ifdef DUP_PH
#define DUP_(n) if (DUP_PH == n) { PH_(n); SYNC_(); }
#else
#define DUP_(n)
#endif
    PH_(0); SYNC_(); DUP_(0) PH_(1); SYNC_(); DUP_(1) PH_(2); SYNC_(); DUP_(2) PH_(3); SYNC_(); DUP_(3) PH_(4); SYNC_(); PH_(5); SYNC_(); PH_(6); SYNC_();
    PH_(7); SYNC_(); DUP_(7) PH_(8); SYNC_(); DUP_(8) PH_(9); SYNC_(); DUP_(9) DUP_(100) PH_(10); SYNC_(); PH_(11); SYNC_(); PH_(12); SYNC_(); DUP_(12) PH_(13); SYNC_(); PH_(14);
#undef PH_
#undef SYNC_
}

static void add_job(Params& p, const float* src, bf16_t* dst, const float* gain, int ldsrc, int K, int nsrc0, int ndst0, int ncols, int f16 = 0) {
    ConvJob& j = p.jobs[p.njobs++];
    j.f16 = f16; j.pad = 0;
    j.src = src; j.dst = dst; j.gain = gain; j.ldsrc = ldsrc; j.K = K; j.nsrc0 = nsrc0; j.ndst0 = ndst0; j.ncols = ncols; j.tile0 = p.nconv_tiles;
    p.nconv_tiles += (K / 64) * ((ncols + 63) / 64);
}

extern "C" void kernel_launch(void* const* d_in, const int* in_sizes, int n_in, void* d_out, int out_size, void* d_ws, size_t ws_size, hipStream_t stream) {
    Params p;
    memset(&p, 0, sizeof(p));
    const float** f = (const float**)d_in;
    p.x = f[0]; p.rel_table = f[1]; p.a_norm = f[2]; p.a_w_in = f[3]; p.a_q_gain = f[4]; p.a_k_gain = f[5]; p.a_sink = f[6]; p.a_w_out = f[7];
    p.kv_norm = f[8]; p.kv_w = f[9]; p.kv_k_gain = f[10]; p.cmp_k_pos = f[11]; p.cmp_k_w1 = f[12]; p.cmp_k_w2 = f[13];
    p.cmp_v_pos = f[14]; p.cmp_v_w1 = f[15]; p.cmp_v_w2 = f[16]; p.b_norm = f[17]; p.b_w_in = f[18]; p.b_q_gain = f[19]; p.b_w_out = f[20];
    p.out = (float*)d_out; p.ws = (char*)d_ws;
    char* ws = (char*)d_ws;
    for (int L = 0; L < 2; ++L) {
        add_job(p, p.a_w_in + (size_t)L * D_ * A_IN, (bf16_t*)(ws + WS_WINA) + (size_t)L * A_IN * D_, p.a_norm + L * D_, A_IN, D_, 0, 0, A_IN, 1);
        add_job(p, p.a_w_out + (size_t)L * D_ * D_, (bf16_t*)(ws + WS_WOUTA) + (size_t)L * D_ * D_, nullptr, D_, D_, 0, 0, D_);
        add_job(p, p.b_w_out + (size_t)L * D_ * D_, (bf16_t*)(ws + WS_WOUTB) + (size_t)L * D_ * D_, nullptr, D_, D_, 0, 0, D_);
    }
    add_job(p, p.kv_w, (bf16_t*)(ws + WS_WKVB0), p.kv_norm, KVW, D_, 0, 0, KVW, 1);
    for (int L = 0; L < 2; ++L) {
        bf16_t* dst = (L == 0) ? (bf16_t*)(ws + WS_WKVB0) + (size_t)KVW * D_ : (bf16_t*)(ws + WS_WINB1);
        const float* src = p.b_w_in + (size_t)L * D_ * 4144;
        const float* gn = p.b_norm + L * D_;
        add_job(p, src, dst, gn, 4144, D_, 0, 0, 1024, 1);
        add_job(p, src, dst, gn, 4144, D_, 1072, 1024, 3072, 1);
        bf16_t* gdst = (L == 0) ? (bf16_t*)(ws + WS_WG0) : dst;
        const int g0 = (L == 0) ? 0 : 4096;
        add_job(p, src, gdst, gn, 4144, D_, 1024, g0, 48, 1);
        add_job(p, nullptr, gdst, nullptr, 4144, D_, 0, g0 + 64, 192);
    }
    add_job(p, p.cmp_k_w1, (bf16_t*)(ws + WS_W1), nullptr, 256, 2048, 0, 0, 256);
    add_job(p, p.cmp_v_w1, (bf16_t*)(ws + WS_W1) + (size_t)256 * 2048, nullptr, 256, 2048, 0, 0, 256);
    add_job(p, p.cmp_k_w2, (bf16_t*)(ws + WS_W2), nullptr, 64, 256, 0, 0, 64);
    add_job(p, nullptr, (bf16_t*)(ws + WS_W2), nullptr, 64, 256, 0, 64, 192);
    add_job(p, p.cmp_v_w2, (bf16_t*)(ws + WS_W2) + (size_t)256 * 256, nullptr, 64, 256, 0, 0, 64);
    add_job(p, nullptr, (bf16_t*)(ws + WS_W2) + (size_t)256 * 256, nullptr, 64, 256, 0, 64, 192);
    static int grid_blocks = 0;
    if (!grid_blocks) {
        int dev = 0, cus = 0, per_cu = 0;
        (void)hipGetDevice(&dev);
        (void)hipDeviceGetAttribute(&cus, hipDeviceAttributeMultiprocessorCount, dev);
        (void)hipFuncSetAttribute((const void*)mega_kernel, hipFuncAttributeMaxDynamicSharedMemorySize, LDS_BYTES);
        (void)hipOccupancyMaxActiveBlocksPerMultiprocessor(&per_cu, mega_kernel, NTHR, LDS_BYTES);
        (void)hipGetLastError();
        grid_blocks = cus;
        if (per_cu < 1) fprintf(stderr, "note: occupancy query reports %d workgroups per CU\n", per_cu);
    }
    void* args[] = {&p};
    (void)hipMemsetAsync(d_ws, 0, 16384, stream);
    hipError_t e = hipLaunchCooperativeKernel((void*)mega_kernel, dim3(grid_blocks), dim3(NTHR), args, LDS_BYTES, stream);
    if (e != hipSuccess) fprintf(stderr, "cooperative launch failed: %s (grid %d)\n", hipGetErrorString(e), grid_blocks);
}
```

```cpp
#include <hip/hip_runtime.h>
#include <hip/hip_cooperative_groups.h>
#include <cstdio>
#include <cstdint>
#include <cstring>
namespace cg = cooperative_groups;
#ifndef PROBE_MODE
#define PROBE_MODE 0
#endif

#define LAS __attribute__((address_space(3)))
typedef unsigned short bf16_t;
typedef short bf16x8 __attribute__((ext_vector_type(8)));
typedef short s16x4 __attribute__((ext_vector_type(4)));
typedef float f32x4 __attribute__((ext_vector_type(4)));
typedef float f32x2 __attribute__((ext_vector_type(2)));
typedef unsigned u32x4 __attribute__((ext_vector_type(4)));
typedef unsigned u32x2 __attribute__((ext_vector_type(2)));
typedef __bf16 bf16x2_t __attribute__((ext_vector_type(2)));
typedef _Float16 h16x2 __attribute__((ext_vector_type(2)));
typedef _Float16 h16x8 __attribute__((ext_vector_type(8)));

constexpr int NTHR = 512;
constexpr int T_ = 32768, S_ = 2048, NB_ = 16, D_ = 1024;
constexpr int A_IN = 2560, B_INP = 4352  , KVW = 1536, KVB_N = KVW + 4096  ;
constexpr float EPS = 1e-6f;
constexpr float LOG2E = 1.4426950408889634f;
constexpr float C1 = 0.125f * LOG2E;
constexpr float NEGBIG = -1e30f;
constexpr int LUTW = 320;

constexpr size_t MiB = 1u << 20;
constexpr size_t WS_LUT = 1 * MiB;
constexpr size_t WS_CB = WS_LUT + 65536;
constexpr size_t WS_PART = 2 * MiB;
constexpr size_t WS_GATES = 4 * MiB;
constexpr size_t WS_WINA = 10 * MiB;
constexpr size_t WS_WOUTA = 20 * MiB;
constexpr size_t WS_WKVB0 = 24 * MiB;
constexpr size_t WS_WINB1 = 36 * MiB;
constexpr size_t WS_WOUTB = 45 * MiB;
constexpr size_t WS_W1 = 49 * MiB;
constexpr size_t WS_W2 = 51 * MiB;
constexpr size_t WS_WG0 = 51 * MiB + 524288;
constexpr size_t WS_XB = 52 * MiB;
constexpr size_t WS_KV = 116 * MiB;
constexpr size_t WS_Q = 212 * MiB;
constexpr size_t WS_Z = 276 * MiB;
constexpr size_t WS_HID = 468 * MiB;
constexpr size_t WS_KCMP = 476 * MiB;
constexpr size_t WS_VCMP = 477 * MiB;

struct ConvJob { const float* src; bf16_t* dst; const float* gain; int ldsrc, K, nsrc0, ndst0, ncols, tile0, f16, pad; };
constexpr int MAXJOBS = 32;

struct Params {
    const float *x, *rel_table, *a_norm, *a_w_in, *a_q_gain, *a_k_gain, *a_sink, *a_w_out;
    const float *kv_norm, *kv_w, *kv_k_gain, *cmp_k_pos, *cmp_k_w1, *cmp_k_w2, *cmp_v_pos, *cmp_v_w1, *cmp_v_w2;
    const float *b_norm, *b_w_in, *b_q_gain, *b_w_out;
    float* out;
    char* ws;
    ConvJob jobs[MAXJOBS];
    int njobs, nconv_tiles;
};

__device__ __forceinline__ unsigned pack2(float a, float b) { f32x2 v = {a, b}; bf16x2_t r = __builtin_convertvector(v, bf16x2_t); return __builtin_bit_cast(unsigned, r); }
__device__ __forceinline__ unsigned pack2h(float a, float b) { f32x2 v = {a, b}; h16x2 r = __builtin_convertvector(v, h16x2); return __builtin_bit_cast(unsigned, r); }
__device__ __forceinline__ f32x2 unpack2h(unsigned u) { return __builtin_convertvector(__builtin_bit_cast(h16x2, u), f32x2); }
__device__ __forceinline__ float bflo(unsigned u) { return __uint_as_float(u << 16); }
__device__ __forceinline__ float bfhi(unsigned u) { return __uint_as_float(u & 0xffff0000u); }
__device__ __forceinline__ float fast_exp2(float x) { return __builtin_amdgcn_exp2f(x); }
__device__ __forceinline__ float fast_rcp(float x) { return __builtin_amdgcn_rcpf(x); }
__device__ __forceinline__ float silu_f(float v) { return v * fast_rcp(1.0f + fast_exp2(-v * LOG2E)); }
__device__ __forceinline__ float sigmoid_f(float v) { return fast_rcp(1.0f + fast_exp2(-v * LOG2E)); }
__device__ __forceinline__ f32x4 mfma16(bf16x8 a, bf16x8 b, f32x4 c) { return __builtin_amdgcn_mfma_f32_16x16x32_bf16(a, b, c, 0, 0, 0); }
__device__ __forceinline__ int opaque_tid() { int t = threadIdx.x; asm volatile("" : "+v"(t)); return t; }

__host__ __device__ __forceinline__ int wperm(int c) { return 128 * ((c >> 5) & 1) + 32 * ((c >> 6) & 3) + 16 * ((c >> 2) & 1) + 4 * ((c >> 3) & 3) + (c & 3); }

constexpr int LDS_K = 0, LDS_V = 16384, LDS_LUT = 32768;
constexpr int LDS_GST = 106496;
constexpr int LDS_TB = 40960;

struct ConvRegs { f32x4 v[2]; float gn[2]; };
__device__ __forceinline__ void conv_load(const Params& p, int u, int tid, ConvRegs& R) {
    int j = 0;
    while (j + 1 < p.njobs && p.jobs[j + 1].tile0 <= u) ++j;
    const ConvJob& J = p.jobs[j];
    const int lt = u - J.tile0, ktiles = J.K >> 6, nt = lt / ktiles, kt = lt - nt * ktiles, k0 = kt * 64, n0 = nt * 64;
#pragma unroll
    for (int i = 0; i < 2; ++i) {
        const int c = tid + NTHR * i, kk = c >> 4, n4 = (c & 15) * 4;
        R.v[i] = (f32x4){0.f, 0.f, 0.f, 0.f};
        if (J.src && n0 + n4 < J.ncols) R.v[i] = *(const f32x4*)(J.src + (size_t)(k0 + kk) * J.ldsrc + J.nsrc0 + n0 + n4);
        R.gn[i] = J.gain ? J.gain[k0 + kk] : 1.0f;
    }
}
__device__ __forceinline__ void conv_finish(const Params& p, LAS char* lds, int u, int tid, const ConvRegs& R) {
    int j = 0;
    while (j + 1 < p.njobs && p.jobs[j + 1].tile0 <= u) ++j;
    const ConvJob& J = p.jobs[j];
    const int lt = u - J.tile0, ktiles = J.K >> 6, nt = lt / ktiles, kt = lt - nt * ktiles, k0 = kt * 64, n0 = nt * 64;
    LAS float* sm = (LAS float*)lds;
    __syncthreads();
#pragma unroll
    for (int i = 0; i < 2; ++i) {
        const int c = tid + NTHR * i, kk = c >> 4, n4 = (c & 15) * 4;
        sm[kk * 65 + n4 + 0] = R.v[i][0] * R.gn[i]; sm[kk * 65 + n4 + 1] = R.v[i][1] * R.gn[i]; sm[kk * 65 + n4 + 2] = R.v[i][2] * R.gn[i]; sm[kk * 65 + n4 + 3] = R.v[i][3] * R.gn[i];
    }
    __syncthreads();
    {
        const int nn = tid >> 3, k8 = (tid & 7) * 8;
        u32x4 w;
        if (J.f16) {
            w[0] = pack2h(sm[(k8 + 0) * 65 + nn], sm[(k8 + 1) * 65 + nn]);
            w[1] = pack2h(sm[(k8 + 2) * 65 + nn], sm[(k8 + 3) * 65 + nn]);
            w[2] = pack2h(sm[(k8 + 4) * 65 + nn], sm[(k8 + 5) * 65 + nn]);
            w[3] = pack2h(sm[(k8 + 6) * 65 + nn], sm[(k8 + 7) * 65 + nn]);
        } else {
            w[0] = pack2(sm[(k8 + 0) * 65 + nn], sm[(k8 + 1) * 65 + nn]);
            w[1] = pack2(sm[(k8 + 2) * 65 + nn], sm[(k8 + 3) * 65 + nn]);
            w[2] = pack2(sm[(k8 + 4) * 65 + nn], sm[(k8 + 5) * 65 + nn]);
            w[3] = pack2(sm[(k8 + 6) * 65 + nn], sm[(k8 + 7) * 65 + nn]);
        }
        const int L = J.ndst0 + n0 + nn;
        const int prow = (L & ~255) + wperm(L & 255);
        *(u32x4*)(J.dst + (size_t)prow * J.K + k0 + k8) = w;
    }
}

__device__ __forceinline__ void phase_prep(const Params& p, LAS char* lds, int bid, int nblk) {
    const int tid = opaque_tid(), lane = tid & 63, wid = tid >> 6;
    const int nconv = p.nconv_tiles;
    if (bid < 32) {
        const int which = bid >> 4, ng = bid & 15;
        const float* pos = which ? p.cmp_v_pos : p.cmp_k_pos;
        const float* w1 = which ? p.cmp_v_w1 : p.cmp_k_w1;
        const int nn = tid & 15, ks = tid >> 4;
        const int n = ng * 16 + nn;
        float a0 = 0.f, a1 = 0.f, a2 = 0.f, a3 = 0.f;
#pragma unroll 4
        for (int k = ks * 64; k < ks * 64 + 64; k += 4) {
            a0 += pos[k] * w1[(size_t)k * 256 + n]; a1 += pos[k + 1] * w1[(size_t)(k + 1) * 256 + n];
            a2 += pos[k + 2] * w1[(size_t)(k + 2) * 256 + n]; a3 += pos[k + 3] * w1[(size_t)(k + 3) * 256 + n];
        }
        LAS float* sm = (LAS float*)lds;
        sm[ks * 16 + nn] = (a0 + a1) + (a2 + a3);
        __syncthreads();
        if (tid < 16) {
            float s = 0.f;
            for (int q = 0; q < 32; ++q) s += sm[q * 16 + tid];
            ((float*)(p.ws + WS_CB))[which * 256 + ng * 16 + tid] = s;
        }
    }
    for (int u = bid; u < 20; u += nblk) {
        const int i = u * NTHR + tid;
        const int variant = i / (16 * LUTW), rem = i - variant * 16 * LUTW, h = rem / LUTW, k = rem - h * LUTW;
        const int d = 255 - k;
        float v = NEGBIG;
        if (d >= 0 && (variant == 1 || d < 128)) {
            int bk;
            if (d < 16) bk = d;
            else { const int dc = d > 127 ? 127 : d; bk = 16 + (int)(logf((float)dc * (1.0f / 16.0f)) / logf(8.0f) * 16.0f); if (bk > 31) bk = 31; }
            v = p.rel_table[bk * 16 + h] * LOG2E;
            if (variant == 1) v -= p.rel_table[31 * 16 + h] * LOG2E;
        }
        ((float*)(p.ws + WS_LUT))[i] = v;
    }
    {
        ConvRegs Ra, Rb;
        int u = bid;
        if (u < nconv) conv_load(p, u, tid, Ra);
        while (u < nconv) {
            const int un = u + nblk;
            if (un < nconv) conv_load(p, un, tid, Rb);
            conv_finish(p, lds, u, tid, Ra);
            u = un;
            if (u >= nconv) break;
            const int un2 = u + nblk;
            if (un2 < nconv) conv_load(p, un2, tid, Ra);
            conv_finish(p, lds, u, tid, Rb);
            u = un2;
        }
    }
    for (int r0 = bid * 16 + wid * 2; r0 < T_; r0 += nblk * 16) {
        f32x4 v[2][4];
#pragma unroll
        for (int rr = 0; rr < 2; ++rr)
#pragma unroll
            for (int i = 0; i < 4; ++i) v[rr][i] = *(const f32x4*)(p.x + (size_t)(r0 + rr) * D_ + i * 256 + lane * 4);
#pragma unroll
        for (int rr = 0; rr < 2; ++rr) {
            bf16_t* xb = (bf16_t*)(p.ws + WS_XB) + (size_t)(r0 + rr) * D_;
            float ss = 0.f;
#pragma unroll
            for (int i = 0; i < 4; ++i) {
                ss += v[rr][i][0] * v[rr][i][0] + v[rr][i][1] * v[rr][i][1] + v[rr][i][2] * v[rr][i][2] + v[rr][i][3] * v[rr][i][3];
                u32x2 w; w[0] = pack2h(v[rr][i][0], v[rr][i][1]); w[1] = pack2h(v[rr][i][2], v[rr][i][3]);
                *(u32x2*)(xb + i * 256 + lane * 4) = w;
            }
#pragma unroll
            for (int o = 32; o >= 1; o >>= 1) ss += __shfl_xor(ss, o);
            if (lane == 0) ((float*)(p.ws + WS_PART))[r0 + rr] = ss;
        }
    }
    for (int i = bid * NTHR + tid; i < 15 * T_ / 4; i += nblk * NTHR) ((f32x4*)(p.ws + WS_PART) + T_ / 4)[i] = (f32x4){0.f, 0.f, 0.f, 0.f};
}

namespace pg8 {
#define PG8_LAS __attribute__((address_space(3)))
constexpr int BM = 256, BK = 64, HALF = 128, HTB = HALF * BK * 2  , STAGE_BYTES = 8 * HTB, NXCD = 8, WGM = 8;
constexpr int PART_OFF = STAGE_BYTES + 256, GAIN_OFF = PART_OFF + 16384;
__host__ __device__ __forceinline__ int lds_byte(int r, int c) { const int rr = r & 7; return (r >> 3) * 1024 + rr * 128 + ((((c >> 3) ^ rr) & 7) << 4) + (c & 7) * 2; }
__host__ __device__ __forceinline__ void stage_rc(int b, int& R, int& C) { const int st = b / 1024, sb = b % 1024, rr = sb >> 7, pch = (sb >> 4) & 7; R = st * 8 + rr; C = (pch ^ rr) << 3; }
__host__ __device__ __forceinline__ int perm32(int rho) { const int n = rho >> 4, i = rho & 15; return 8 * (i >> 2) + 4 * n + (i & 3); }
struct Unit { int pm, pn; };
struct Gemm { const bf16_t* A; const bf16_t* Bt; int M, N, K; };
struct StaticOrder {
    int nM, nN, nwg, G, c;
    __host__ __device__ void init(int M, int N, int G_, int c_) { nM = M / BM; nN = N / BM; nwg = nM * nN; G = G_; c = c_; }
    __host__ __device__ bool next(int i, Unit& u) const {
        const long L = (long)i * G + c; if (L >= nwg) return false;
        int wgid = (int)L; { const int q = nwg / NXCD, r = nwg % NXCD, xcd = wgid % NXCD, off = wgid / NXCD; wgid = (xcd < r ? xcd * (q + 1) : r * (q + 1) + (xcd - r) * q) + off; }
        const int nig = WGM * nN, gid = wgid / nig, fm = gid * WGM, gsz = (nM - fm) < WGM ? (nM - fm) : WGM;
        u.pm = fm + ((wgid % nig) % gsz); u.pn = (wgid % nig) / gsz; return true;
    }
    __device__ __forceinline__ void a_ready(const Unit&) const {}
    __device__ __forceinline__ void done(const Unit&) const {}
};
struct ALinear { int lda;
    __device__ __forceinline__ size_t base(int pm) const { return (size_t)pm * 256 * lda * 2; }
    __device__ __forceinline__ size_t hstep() const { return (size_t)128 * lda * 2; }
    __device__ __forceinline__ size_t kstep() const { return 128; }
    __device__ __forceinline__ int rowstride() const { return lda; } };
struct ACmp { int colbase;
    __device__ __forceinline__ size_t base(int pm) const { const int bh = 2 * pm; return ((size_t)(bh >> 2) * S_ * KVW + colbase + (bh & 3) * 64) * 2; }
    __device__ __forceinline__ size_t hstep() const { return 128; }
    __device__ __forceinline__ size_t kstep() const { return (size_t)KVW * 2; }
    __device__ __forceinline__ int rowstride() const { return 16 * KVW; } };

template <bool F16> __device__ __forceinline__ f32x4 mma16(bf16x8 b, bf16x8 a, f32x4 c) {
    if constexpr (F16) return __builtin_amdgcn_mfma_f32_16x16x32_f16(__builtin_bit_cast(h16x8, b), __builtin_bit_cast(h16x8, a), c, 0, 0, 0);
    else return __builtin_amdgcn_mfma_f32_16x16x32_bf16(b, a, c, 0, 0, 0);
}
template <class Epi, class Sched, class AFn, bool ALIGN_EPI = false, bool SP2 = false, bool F16 = false>
__device__ __forceinline__ void gemm_phase(PG8_LAS unsigned char* lds, const Gemm g, const Sched& S, const Epi& E, const AFn& AF) {
    const int tid = ::opaque_tid(), wid = __builtin_amdgcn_readfirstlane(tid >> 6), lane = tid & 63, wr = wid >> 2, wc = wid & 3, fr = lane & 15, fq = lane >> 4;
    const int K = g.K, nt = K / BK;
    unsigned voffA[2], voffB[2];
#pragma unroll
    for (int i = 0; i < 2; ++i) { int R, C; stage_rc(tid * 16 + i * 8192, R, C); const int Rb = Epi::PERM ? ((R & ~31) + perm32(R & 31)) : R;
        voffA[i] = (unsigned)(R * AF.rowstride() + C) * 2u; voffB[i] = (unsigned)(Rb * K + C) * 2u; }
    const size_t kstepB = (size_t)(BK * 2), kstepA = AF.kstep();
    const size_t hstepB = (size_t)HALF * K * 2, hstepA = AF.hstep();
    const size_t tstepB = 2 * hstepB;
    const unsigned ldsw = (unsigned)wid * 1024u;
    const int aoff[2] = {lds_byte(wr * 64 + fr, fq * 8), lds_byte(wr * 64 + fr, fq * 8 + 32)}, boff[2] = {lds_byte(wc * 32 + fr, fq * 8), lds_byte(wc * 32 + fr, fq * 8 + 32)};
#define PG8_SA(b, h) (((b) * 2 + (h)) * HTB)
#define PG8_SB(b, h) ((4 + (b) * 2 + (h)) * HTB)
#define PG8_STAGE(bufoff, gbase, voff) do { _Pragma("unroll") for (int _i = 0; _i < 2; ++_i) \
        __builtin_amdgcn_global_load_lds((const unsigned*)((const char*)(gbase) + (voff)[_i]), (PG8_LAS unsigned*)(lds + (bufoff) + ldsw + _i * 8192), 16, 0, 0); } while (0)
#define PG8_LDA(dst, b, h) do { _Pragma("unroll") for (int m = 0; m < 4; ++m) _Pragma("unroll") for (int k = 0; k < 2; ++k) dst[m][k] = *(const PG8_LAS bf16x8*)(lds + PG8_SA(b, h) + aoff[k] + m * 2048); } while (0)
#define PG8_LDB(dst, b, h) do { _Pragma("unroll") for (int n = 0; n < 2; ++n) _Pragma("unroll") for (int k = 0; k < 2; ++k) dst[n][k] = *(const PG8_LAS bf16x8*)(lds + PG8_SB(b, h) + boff[k] + n * 2048); } while (0)
#define PG8_MMA(ai, bj, At, Bt) do { __builtin_amdgcn_s_setprio(1); _Pragma("unroll") for (int m = 0; m < 4; ++m) _Pragma("unroll") for (int n = 0; n < 2; ++n) _Pragma("unroll") for (int k = 0; k < 2; ++k) \
        acc[ai][bj][m][n] = mma16<F16>(Bt[n][k], At[m][k], acc[ai][bj][m][n]); __builtin_amdgcn_s_setprio(0); } while (0)
#define PG8_WAIT_V(n) asm volatile("s_waitcnt vmcnt(" #n ")" ::: "memory")
#define PG8_WAIT_L(n) asm volatile("s_waitcnt lgkmcnt(" #n ")" ::: "memory")
#define PG8_BAR __builtin_amdgcn_s_barrier()
#define PG8_SCHED __builtin_amdgcn_sched_barrier(0)
    Unit cur, nxt; int ui = 0;
    if (!S.next(0, cur)) return;
    if constexpr (Epi::LDSAUX) E.fill_gains(lds, tid);
    int pend = 0;
    f32x4 acc[2][2][4][2];
#pragma unroll
    for (int a = 0; a < 2; ++a)
#pragma unroll
        for (int b = 0; b < 2; ++b)
#pragma unroll
            for (int m = 0; m < 4; ++m)
#pragma unroll
                for (int n = 0; n < 2; ++n) acc[a][b][m][n] = (f32x4){0.f, 0.f, 0.f, 0.f};
    bf16x8 At[4][2], B0[2][2], B1[2][2];
    const char* cA = (const char*)g.A + AF.base(cur.pm); const char* cB = (const char*)g.Bt + (size_t)cur.pn * tstepB;
    S.a_ready(cur);
    if constexpr (SP2) {
        PG8_STAGE(PG8_SB(0, 0), cB, voffB); PG8_STAGE(PG8_SB(0, 1), cB + hstepB, voffB); PG8_STAGE(PG8_SA(0, 0), cA, voffA); PG8_STAGE(PG8_SA(0, 1), cA + hstepA, voffA);
        if (wr == 1) PG8_BAR;
        PG8_WAIT_V(2); PG8_BAR;
        PG8_STAGE(PG8_SB(1, 0), cB + kstepB, voffB); PG8_STAGE(PG8_SA(1, 0), cA + kstepA, voffA); PG8_STAGE(PG8_SB(1, 1), cB + hstepB + kstepB, voffB);
        PG8_WAIT_V(6); PG8_BAR;
    } else {
        PG8_STAGE(PG8_SB(0, 0), cB, voffB); PG8_STAGE(PG8_SA(0, 0), cA, voffA); PG8_STAGE(PG8_SB(0, 1), cB + hstepB, voffB); PG8_STAGE(PG8_SA(0, 1), cA + hstepA, voffA);
        if (wr == 1) PG8_BAR;
        PG8_WAIT_V(4); PG8_BAR;
        PG8_STAGE(PG8_SB(1, 0), cB + kstepB, voffB); PG8_STAGE(PG8_SA(1, 0), cA + kstepA, voffA); PG8_STAGE(PG8_SB(1, 1), cB + hstepB + kstepB, voffB);
        PG8_WAIT_V(6); PG8_BAR;
    }
    for (;;) {
        const bool has_next = S.next(ui + 1, nxt);
        const char* nA = has_next ? (const char*)g.A + AF.base(nxt.pm) : cA; const char* nB = has_next ? (const char*)g.Bt + (size_t)nxt.pn * tstepB : cB;
#pragma unroll 1
        for (int t = 0; t < nt; t += 2) {
            const bool last = (t == nt - 2);
            const char* a1 = cA + (size_t)(t + 1) * kstepA;
            const char* a2 = last ? nA : cA + (size_t)(t + 2) * kstepA; const char* b2 = last ? nB : cB + (size_t)(t + 2) * kstepB;
            const char* a3 = a2 + kstepA; const char* b3 = b2 + kstepB;
            if (last && has_next) S.a_ready(nxt);
            int wm = 0;
            if constexpr (Epi::LDSAUX) { wm = __builtin_amdgcn_readfirstlane((t == 0) ? (pend == 16 ? 2 : 1) : 0); asm volatile("" : "+s"(wm)); }
            if constexpr (SP2) {
            PG8_LDB(B0, 0, 0); PG8_LDB(B1, 0, 1); PG8_SCHED; PG8_LDA(At, 0, 0); PG8_STAGE(PG8_SA(1, 1), a1 + hstepA, voffA);
            if (Epi::LDSAUX && wm == 2) { PG8_WAIT_V(24); } else { PG8_WAIT_V(8); }
            PG8_WAIT_L(0); PG8_BAR; PG8_MMA(0, 0, At, B0); PG8_MMA(0, 1, At, B1); PG8_BAR; PG8_SCHED;
            PG8_LDA(At, 0, 1);
            if (Epi::LDSAUX && wm != 0) {
                const char* pp = (const char*)E.part + ((size_t)wid * T_ + cur.pm * 256) * 4 + (size_t)(::opaque_tid() & 63) * 16;
#pragma unroll
                for (int i = 0; i < 2; ++i) __builtin_amdgcn_global_load_lds((const unsigned*)(pp + (size_t)i * 8 * T_ * 4), (PG8_LAS unsigned*)(lds + PART_OFF + (i * 8 + wid) * 1024), 16, 0, 0);
            }
            PG8_STAGE(PG8_SB(0, 0), b2, voffB); PG8_STAGE(PG8_SB(0, 1), b2 + hstepB, voffB); PG8_STAGE(PG8_SA(0, 0), a2, voffA);
            if (Epi::LDSAUX && wm != 0) { if (wm == 2) { PG8_WAIT_V(26); } else { PG8_WAIT_V(10); } } else { PG8_WAIT_V(8); }
            PG8_WAIT_L(0); PG8_BAR; PG8_MMA(1, 0, At, B0); PG8_MMA(1, 1, At, B1); PG8_BAR; PG8_SCHED;
            PG8_LDB(B0, 1, 0); PG8_LDB(B1, 1, 1); PG8_SCHED; PG8_LDA(At, 1, 0); PG8_STAGE(PG8_SA(0, 1), a2 + hstepA, voffA);
            PG8_WAIT_V(8); PG8_WAIT_L(0); PG8_BAR; PG8_MMA(0, 0, At, B0); PG8_MMA(0, 1, At, B1); PG8_BAR; PG8_SCHED;
            PG8_LDA(At, 1, 1); PG8_STAGE(PG8_SB(1, 0), b3, voffB); PG8_STAGE(PG8_SB(1, 1), b3 + hstepB, voffB); PG8_STAGE(PG8_SA(1, 0), a3, voffA);
            PG8_WAIT_V(8); PG8_WAIT_L(0); PG8_BAR; PG8_MMA(1, 0, At, B0); PG8_MMA(1, 1, At, B1); PG8_BAR; PG8_SCHED;
            } else {
            PG8_LDB(B0, 0, 0); PG8_SCHED; PG8_LDA(At, 0, 0); PG8_STAGE(PG8_SA(1, 1), a1 + hstepA, voffA);
            PG8_WAIT_L(8); PG8_BAR; PG8_WAIT_L(0); PG8_MMA(0, 0, At, B0); PG8_BAR; PG8_SCHED;
            PG8_LDB(B1, 0, 1); PG8_STAGE(PG8_SB(0, 0), b2, voffB);
            PG8_BAR; PG8_WAIT_L(0); PG8_MMA(0, 1, At, B1); PG8_BAR;
            PG8_LDA(At, 0, 1); PG8_STAGE(PG8_SA(0, 0), a2, voffA);
            PG8_BAR; PG8_WAIT_L(0); PG8_MMA(1, 0, At, B0); PG8_BAR; PG8_SCHED;
            PG8_STAGE(PG8_SB(0, 1), b2 + hstepB, voffB);
            PG8_WAIT_V(6); PG8_BAR; PG8_MMA(1, 1, At, B1); PG8_BAR;
            PG8_LDB(B0, 1, 0); PG8_SCHED; PG8_LDA(At, 1, 0); PG8_STAGE(PG8_SA(0, 1), a2 + hstepA, voffA);
            PG8_WAIT_L(8); PG8_BAR; PG8_WAIT_L(0); PG8_MMA(0, 0, At, B0); PG8_BAR; PG8_SCHED;
            PG8_LDB(B1, 1, 1); PG8_STAGE(PG8_SB(1, 0), b3, voffB);
            PG8_BAR; PG8_WAIT_L(0); PG8_MMA(0, 1, At, B1); PG8_BAR;
            PG8_LDA(At, 1, 1); PG8_STAGE(PG8_SA(1, 0), a3, voffA);
            PG8_BAR; PG8_WAIT_L(0); PG8_MMA(1, 0, At, B0); PG8_BAR; PG8_SCHED;
            PG8_STAGE(PG8_SB(1, 1), b3 + hstepB, voffB);
            PG8_WAIT_V(6); PG8_BAR; PG8_MMA(1, 1, At, B1); PG8_BAR;
            }
        }
        if constexpr (ALIGN_EPI) { if (wr == 0) PG8_BAR; }
        if constexpr (!Epi::AFTER_DRAIN) { pend = E(acc, cur, wr, wc, fr, fq, lds); S.done(cur); }
        if (!has_next) break;
#pragma unroll
        for (int a = 0; a < 2; ++a)
#pragma unroll
            for (int b = 0; b < 2; ++b)
#pragma unroll
                for (int m = 0; m < 4; ++m)
#pragma unroll
                    for (int n = 0; n < 2; ++n) acc[a][b][m][n] = (f32x4){0.f, 0.f, 0.f, 0.f};
        cur = nxt; cA = nA; cB = nB; ++ui;
        if constexpr (ALIGN_EPI) { if (wr == 1) PG8_BAR; }
    }
    PG8_WAIT_V(0);
    if constexpr (!ALIGN_EPI) { if (wr == 0) PG8_BAR; }
    PG8_BAR;
    if constexpr (Epi::AFTER_DRAIN) { E.fused(acc, cur, wr, wc, fr, fq, lds, wid, lane); S.done(cur); }
#undef PG8_SA
#undef PG8_SB
#undef PG8_STAGE
#undef PG8_LDA
#undef PG8_LDB
#undef PG8_MMA
#undef PG8_WAIT_V
#undef PG8_WAIT_L
#undef PG8_BAR
#undef PG8_SCHED
}

}

enum { M_PLAIN = 0, M_NORM = 1, M_SIGM = 2, M_SKIP = 3, M_SILUB = 4, M_NORMZ = 5  , M_PLAINZ = 6, M_NORMQ = 7  , M_SILU = 8   };
struct GroupInfo { int mode; bf16_t* dst; int ld; const float* aux; float* fdst; int auxidx; };

template <class GroupFn>
struct EpiProj {
    static constexpr bool PERM = false, AFTER_DRAIN = false, LDSAUX = GroupFn::LDSAUX;
    const float* part;
    GroupFn gf;
    __device__ __forceinline__ void fill_gains(PG8_LAS unsigned char* lds, int tid) const {
        if (tid < 256) { const float* gp = gf.gainp(tid >> 6); if (gp) ((PG8_LAS float*)(lds + pg8::GAIN_OFF))[tid] = gp[tid & 63]; }
    }
    template <int MODE>
    __device__ __forceinline__ void body(const f32x4 (&acc)[2][2][4][2], const pg8::Unit& u, int wr, int fr, int fq, const GroupInfo& gi, PG8_LAS unsigned char* lds) const {
        { const int tt = ::opaque_tid(); fr = tt & 15; fq = (tt >> 4) & 3; }
        constexpr bool NRM = (MODE == M_NORM || MODE == M_NORMZ || MODE == M_NORMQ);
        constexpr bool ZR = (MODE == M_NORMZ || MODE == M_PLAINZ);
        f32x4 aux[2][2];
        if (NRM || MODE == M_SILUB) {
            if (LDSAUX) {
                const unsigned ga = (unsigned)(uintptr_t)(lds + pg8::GAIN_OFF) + gi.auxidx * 256 + fq * 32;
                asm volatile("ds_read_b128 %0, %4\n\tds_read_b128 %1, %4 offset:16\n\tds_read_b128 %2, %4 offset:128\n\tds_read_b128 %3, %4 offset:144\n\ts_waitcnt lgkmcnt(0)"
                             : "=&v"(aux[0][0]), "=&v"(aux[0][1]), "=&v"(aux[1][0]), "=&v"(aux[1][1]) : "v"(ga) : "memory");
            } else {
            int fqo = fq; asm volatile("" : "+v"(fqo));
#pragma unroll
            for (int bj = 0; bj < 2; ++bj)
#pragma unroll
                for (int n = 0; n < 2; ++n) aux[bj][n] = *(const f32x4*)(gi.aux + 32 * bj + 8 * fqo + 4 * n);
            }
        }
        const bool odd = fr & 1;
        bf16_t* const rowp0 = (MODE == M_SIGM) ? nullptr : gi.dst + (size_t)(u.pm * 256 + wr * 64 + (fr & ~1)) * gi.ld + 8 * fq + (odd ? 32 : 0);
#pragma unroll
        for (int ai = 0; ai < 2; ++ai) {
            float rs[4] = {1.0f, 1.0f, 1.0f, 1.0f};
            if (LDSAUX) {
                const unsigned pa = (unsigned)(uintptr_t)(lds + pg8::PART_OFF) + (wr * 64 + (fq * 16 + fr)) * 4 + ai * 512;
                float q[16];
                asm volatile("ds_read_b32 %0, %16\n\tds_read_b32 %1, %16 offset:1024\n\tds_read_b32 %2, %16 offset:2048\n\tds_read_b32 %3, %16 offset:3072\n\t"
                             "ds_read_b32 %4, %16 offset:4096\n\tds_read_b32 %5, %16 offset:5120\n\tds_read_b32 %6, %16 offset:6144\n\tds_read_b32 %7, %16 offset:7168\n\t"
                             "ds_read_b32 %8, %16 offset:8192\n\tds_read_b32 %9, %16 offset:9216\n\tds_read_b32 %10, %16 offset:10240\n\tds_read_b32 %11, %16 offset:11264\n\t"
                             "ds_read_b32 %12, %16 offset:12288\n\tds_read_b32 %13, %16 offset:13312\n\tds_read_b32 %14, %16 offset:14336\n\tds_read_b32 %15, %16 offset:15360\n\ts_waitcnt lgkmcnt(0)"
                             : "=&v"(q[0]), "=&v"(q[1]), "=&v"(q[2]), "=&v"(q[3]), "=&v"(q[4]), "=&v"(q[5]), "=&v"(q[6]), "=&v"(q[7]),
                               "=&v"(q[8]), "=&v"(q[9]), "=&v"(q[10]), "=&v"(q[11]), "=&v"(q[12]), "=&v"(q[13]), "=&v"(q[14]), "=&v"(q[15]) : "v"(pa) : "memory");
                const float sl = (((q[0] + q[1]) + (q[2] + q[3])) + ((q[4] + q[5]) + (q[6] + q[7]))) + (((q[8] + q[9]) + (q[10] + q[11])) + ((q[12] + q[13]) + (q[14] + q[15])));
                const float rl = rsqrtf(sl * (1.0f / D_) + EPS);
#pragma unroll
                for (int m = 0; m < 4; ++m) rs[m] = __shfl(rl, m * 16 + fr);
            }
#pragma unroll
            for (int m = 0; m < 4; ++m) {
                const int row = u.pm * 256 + ai * 128 + wr * 64 + m * 16 + fr;
                f32x4 v[2][2];
#pragma unroll
                for (int bj = 0; bj < 2; ++bj)
#pragma unroll
                    for (int n = 0; n < 2; ++n) v[bj][n] = acc[ai][bj][m][n] * rs[m];
                if (NRM) {
                    float ss = 0.f;
#pragma unroll
                    for (int bj = 0; bj < 2; ++bj)
#pragma unroll
                        for (int n = 0; n < 2; ++n) ss += (v[bj][n][0] * v[bj][n][0] + v[bj][n][1] * v[bj][n][1]) + (v[bj][n][2] * v[bj][n][2] + v[bj][n][3] * v[bj][n][3]);
                    ss += __shfl_xor(ss, 16); ss += __shfl_xor(ss, 32);
                    const float inv = rsqrtf(ss * (1.0f / 64.0f) + EPS) * (MODE == M_NORMQ ? C1 : 1.0f);
#pragma unroll
                    for (int bj = 0; bj < 2; ++bj)
#pragma unroll
                        for (int n = 0; n < 2; ++n) v[bj][n] = v[bj][n] * inv * aux[bj][n];
                } else if (MODE == M_SILU) {
#pragma unroll
                    for (int bj = 0; bj < 2; ++bj)
#pragma unroll
                        for (int n = 0; n < 2; ++n) {
#pragma unroll
                            for (int r = 0; r < 4; ++r) v[bj][n][r] = silu_f(v[bj][n][r]); }
                } else if (MODE == M_SILUB) {
#pragma unroll
                    for (int bj = 0; bj < 2; ++bj)
#pragma unroll
                        for (int n = 0; n < 2; ++n) {
#pragma unroll
                            for (int r = 0; r < 4; ++r) v[bj][n][r] = silu_f(v[bj][n][r] + aux[bj][n][r]); }
                }
                if (ZR) {
                    if ((row & 127) == 127) {
#pragma unroll
                        for (int bj = 0; bj < 2; ++bj)
#pragma unroll
                            for (int n = 0; n < 2; ++n) v[bj][n] = (f32x4){0.f, 0.f, 0.f, 0.f};
                    }
                }
                if (MODE == M_SIGM) {
#pragma unroll
                    for (int bj = 0; bj < 2; ++bj) {
                        if (32 * bj + 8 * fq < 48) {
#pragma unroll
                            for (int n = 0; n < 2; ++n) { f32x4 sg;
#pragma unroll
                                for (int r = 0; r < 4; ++r) sg[r] = sigmoid_f(v[bj][n][r]);
                                *(f32x4*)(gi.fdst + (size_t)row * 48 + 32 * bj + 8 * fq + 4 * n) = sg; }
                        }
                    }
                } else {
                    u32x4 w[2];
#pragma unroll
                    for (int bj = 0; bj < 2; ++bj) { w[bj][0] = pack2(v[bj][0][0], v[bj][0][1]); w[bj][1] = pack2(v[bj][0][2], v[bj][0][3]); w[bj][2] = pack2(v[bj][1][0], v[bj][1][1]); w[bj][3] = pack2(v[bj][1][2], v[bj][1][3]); }
                    u32x4 wa, wb;
#pragma unroll
                    for (int e = 0; e < 4; ++e) {
                        const unsigned give = odd ? w[0][e] : w[1][e];
                        const unsigned recv = (unsigned)__builtin_amdgcn_mov_dpp((int)give, 0xB1, 0xF, 0xF, true);
                        wa[e] = odd ? recv : w[0][e];
                        wb[e] = odd ? w[1][e] : recv;
                    }
                    bf16_t* const rp = rowp0 + (size_t)((ai * 8 + m) * 16) * gi.ld;
                    __builtin_nontemporal_store(wa, (u32x4*)rp);
                    __builtin_nontemporal_store(wb, (u32x4*)(rp + gi.ld));
                }
            }
        }
    }
    __device__ __forceinline__ int operator()(const f32x4 (&acc)[2][2][4][2], const pg8::Unit& u, int wr, int wc, int fr, int fq, PG8_LAS unsigned char* lds) const {
        const GroupInfo gi = gf(u.pn * 4 + wc);
        constexpr unsigned MM = GroupFn::MODES;
        if ((MM >> M_PLAIN & 1) && gi.mode == M_PLAIN) { body<M_PLAIN>(acc, u, wr, fr, fq, gi, lds); return LDSAUX ? 16 : 0; }
        else if ((MM >> M_NORM & 1) && gi.mode == M_NORM) { body<M_NORM>(acc, u, wr, fr, fq, gi, lds); return LDSAUX ? 16 : 0; }
        else if ((MM >> M_NORMQ & 1) && gi.mode == M_NORMQ) { body<M_NORMQ>(acc, u, wr, fr, fq, gi, lds); return LDSAUX ? 16 : 0; }
        else if ((MM >> M_SILU & 1) && gi.mode == M_SILU) { body<M_SILU>(acc, u, wr, fr, fq, gi, lds); return LDSAUX ? 16 : 0; }
        else if ((MM >> M_SIGM & 1) && gi.mode == M_SIGM) body<M_SIGM>(acc, u, wr, fr, fq, gi, lds);
        else if ((MM >> M_SILUB & 1) && gi.mode == M_SILUB) body<M_SILUB>(acc, u, wr, fr, fq, gi, lds);
        else if ((MM >> M_NORMZ & 1) && gi.mode == M_NORMZ) body<M_NORMZ>(acc, u, wr, fr, fq, gi, lds);
        else if ((MM >> M_PLAINZ & 1) && gi.mode == M_PLAINZ) body<M_PLAINZ>(acc, u, wr, fr, fq, gi, lds);
        return 0;
    }
};

template <bool LAST>
struct EpiOut {
    static constexpr bool PERM = false, AFTER_DRAIN = false, LDSAUX = false;
    bf16_t* xh; float* out; float* part;
    static __device__ __forceinline__ unsigned nb(unsigned v) { return (unsigned)__builtin_amdgcn_mov_dpp((int)v, 0xB1, 0xF, 0xF, true); }
    __device__ __forceinline__ int operator()(const f32x4 (&acc)[2][2][4][2], const pg8::Unit& u, int wr, int wc, int fr, int fq, PG8_LAS unsigned char*) const {
        { const int tt = ::opaque_tid(); fr = tt & 15; fq = (tt >> 4) & 3; }
        const bool odd = fr & 1;
        const size_t lane0 = (size_t)(u.pm * 256 + wr * 64 + (fr & ~1)) * D_ + u.pn * 256 + 64 * wc;
        bf16_t* const xp = xh + lane0 + 8 * fq + (odd ? 32 : 0);
#pragma unroll
        for (int ai = 0; ai < 2; ++ai) {
            u32x4 xa[4], xb[4];
            float ssel = 0.f;
#pragma unroll
            for (int m = 0; m < 4; ++m) { xa[m] = *(const u32x4*)(xp + (size_t)(ai * 128 + m * 16) * D_); xb[m] = *(const u32x4*)(xp + (size_t)(ai * 128 + m * 16 + 1) * D_); }
#pragma unroll
            for (int m = 0; m < 4; ++m) {
                u32x4 xo[2];
#pragma unroll
                for (int e = 0; e < 4; ++e) { const unsigned recv = nb(odd ? xa[m][e] : xb[m][e]); xo[0][e] = odd ? recv : xa[m][e]; xo[1][e] = odd ? xb[m][e] : recv; }
                float ss = 0.f;
                f32x4 x0[2], x1[2];
#pragma unroll
                for (int bj = 0; bj < 2; ++bj) {
                    const f32x2 a0 = unpack2h(xo[bj][0]), a1 = unpack2h(xo[bj][1]), a2 = unpack2h(xo[bj][2]), a3 = unpack2h(xo[bj][3]);
                    x0[bj] = (f32x4){a0[0], a0[1], a1[0], a1[1]} + acc[ai][bj][m][0]; x1[bj] = (f32x4){a2[0], a2[1], a3[0], a3[1]} + acc[ai][bj][m][1];
                }
                if (LAST) {
                    float* const op = out + lane0 + (size_t)(ai * 128 + m * 16) * D_ + 8 * fq + (odd ? 4 : 0);
#pragma unroll
                    for (int bj = 0; bj < 2; ++bj) {
                        f32x4 oa, ob;
#pragma unroll
                        for (int e = 0; e < 4; ++e) {
                            const float recv = __builtin_bit_cast(float, nb(__builtin_bit_cast(unsigned, odd ? x0[bj][e] : x1[bj][e])));
                            oa[e] = odd ? recv : x0[bj][e]; ob[e] = odd ? x1[bj][e] : recv;
                        }
                        *(f32x4*)(op + 32 * bj) = oa; *(f32x4*)(op + 32 * bj + D_) = ob;
                    }
                } else {
                    u32x4 w[2];
#pragma unroll
                    for (int bj = 0; bj < 2; ++bj) {
                        w[bj][0] = pack2h(x0[bj][0], x0[bj][1]); w[bj][1] = pack2h(x0[bj][2], x0[bj][3]); w[bj][2] = pack2h(x1[bj][0], x1[bj][1]); w[bj][3] = pack2h(x1[bj][2], x1[bj][3]);
                        ss += ((x0[bj][0] * x0[bj][0] + x0[bj][1] * x0[bj][1]) + (x0[bj][2] * x0[bj][2] + x0[bj][3] * x0[bj][3])) + ((x1[bj][0] * x1[bj][0] + x1[bj][1] * x1[bj][1]) + (x1[bj][2] * x1[bj][2] + x1[bj][3] * x1[bj][3]));
                    }
                    u32x4 wa, wb;
#pragma unroll
                    for (int e = 0; e < 4; ++e) { const unsigned recv = nb(odd ? w[0][e] : w[1][e]); wa[e] = odd ? recv : w[0][e]; wb[e] = odd ? w[1][e] : recv; }
                    *(u32x4*)(xp + (size_t)(ai * 128 + m * 16) * D_) = wa; *(u32x4*)(xp + (size_t)(ai * 128 + m * 16 + 1) * D_) = wb;
                    ss += __shfl_xor(ss, 16); ss += __shfl_xor(ss, 32);
                    if (fq == m) ssel = ss;
                }
            }
            if (!LAST) part[(size_t)(u.pn * 4 + wc) * T_ + u.pm * 256 + ai * 128 + wr * 64 + fq * 16 + fr] = ssel;
            asm volatile("" ::: "memory");
        }
        return 0;
    }
};

struct GfA {
    static constexpr unsigned MODES = 1u << M_PLAIN | 1u << M_NORM | 1u << M_NORMQ | 1u << M_SILU;
    static constexpr bool LDSAUX = true;
    bf16_t* proj; const float* qg; const float* kg;
    __device__ __forceinline__ const float* gainp(int j) const { return j == 0 ? qg : (j == 1 ? kg : nullptr); }
    __device__ __forceinline__ GroupInfo operator()(int G) const {
        GroupInfo gi; gi.dst = proj + G * 64; gi.ld = A_IN; gi.fdst = nullptr; gi.aux = nullptr; gi.mode = M_PLAIN; gi.auxidx = 0;
        if (G < 16) { gi.mode = M_NORMQ; gi.aux = qg; } else if (G < 20) { gi.mode = M_NORM; gi.aux = kg; gi.auxidx = 1; } else if (G >= 24) gi.mode = M_SILU;
        return gi;
    }
};
struct GfB {
    static constexpr unsigned MODES = 1u << M_PLAIN | 1u << M_NORM | 1u << M_NORMQ | 1u << M_SIGM | 1u << M_SILU;
    static constexpr bool LDSAUX = true;
    __device__ __forceinline__ const float* gainp(int j) const { return j == 0 ? qg : (j == 1 ? kvg + 64 : (j == 2 ? kvg + 128 : nullptr)); }
    int kvgroups; bf16_t* kv; const float* kvg; bf16_t* q; bf16_t* z; float* gates; const float* qg;
    __device__ __forceinline__ GroupInfo operator()(int G) const {
        GroupInfo gi; gi.fdst = nullptr; gi.aux = nullptr; gi.mode = M_PLAIN; gi.dst = nullptr; gi.ld = 0; gi.auxidx = 0;
        if (G < kvgroups) {
            gi.dst = kv + G * 64; gi.ld = KVW;
            const int s = G >> 2;
            if (s == 2) { gi.mode = M_NORM; gi.aux = kvg + 64; gi.auxidx = 1; } else if (s == 4) { gi.mode = M_NORM; gi.aux = kvg + 128; gi.auxidx = 2; }
            return gi;
        }
        const int Gp = G - kvgroups;
        if (Gp < 16) { gi.mode = M_NORMQ; gi.aux = qg; gi.dst = q + Gp * 64; gi.ld = D_; }
        else if (Gp < 64) { gi.mode = M_SILU; gi.dst = z + (Gp - 16) * 64; gi.ld = 3072; }
        else if (Gp == 64) { gi.mode = M_SIGM; gi.fdst = gates; }
        else gi.mode = M_SKIP;
        return gi;
    }
};
struct GfG {
    static constexpr unsigned MODES = 1u << M_SIGM;
    static constexpr bool LDSAUX = true;
    __device__ __forceinline__ const float* gainp(int) const { return nullptr; }
    float* gates;
    __device__ __forceinline__ GroupInfo operator()(int G) const { GroupInfo gi; gi.dst = nullptr; gi.ld = 0; gi.aux = nullptr; gi.fdst = gates; gi.auxidx = 0; gi.mode = (G == 0) ? M_SIGM : M_SKIP; return gi; }
};
struct GfC1 {
    static constexpr unsigned MODES = 1u << M_SILUB;
    static constexpr bool LDSAUX = false;
    bf16_t* hid; const float* cb;
    __device__ __forceinline__ GroupInfo operator()(int G) const { GroupInfo gi; gi.mode = M_SILUB; gi.dst = hid + G * 64; gi.ld = 256; gi.aux = cb + G * 64; gi.fdst = nullptr; gi.auxidx = 0; return gi; }
};
template <int ISK> struct GfC2 {
    static constexpr unsigned MODES = ISK ? 1u << M_NORMZ : 1u << M_PLAINZ;
    static constexpr bool LDSAUX = false;
    bf16_t* dst; const float* gain;
    __device__ __forceinline__ GroupInfo operator()(int G) const { GroupInfo gi; gi.dst = dst; gi.ld = 64; gi.aux = gain; gi.fdst = nullptr; gi.auxidx = 0;
        gi.mode = (G != 0) ? M_SKIP : (ISK ? M_NORMZ : M_PLAINZ); return gi; }
};


__device__ __forceinline__ void glds16(const void* gsrc, unsigned lds_dst) {
    unsigned keep;
    asm volatile("s_mov_b32 %0, m0\n\ts_mov_b32 m0, %2\n\ts_nop 0\n\tglobal_load_lds_dwordx4 %1, off\n\ts_mov_b32 m0, %0" : "=&s"(keep) : "v"(gsrc), "s"(lds_dst) : "memory");
}
__device__ __forceinline__ void dma_rows(int tid, LAS char* dst, const bf16_t* src, size_t ld, int nrows, bool vswz) {
    const int lane = tid & 63, wid = __builtin_amdgcn_readfirstlane(tid >> 6);
    const int r = 8 * wid + (lane >> 3), slot = lane & 7;
    const int chn = vswz ? (slot ^ (((r >> 1) & 3) << 1)) : (slot ^ ((r >> 1) & 7));
    const bf16_t* s0 = src + (size_t)r * ld + chn * 8;
    const unsigned d0 = (unsigned)__builtin_amdgcn_readfirstlane((int)(unsigned)(uintptr_t)(dst + wid * 1024));
    glds16(s0, d0);
    if (nrows == 128) glds16(s0 + 64 * ld, d0 + 8192u);
}
#define DMA_WAIT() asm volatile("s_waitcnt vmcnt(0)" ::: "memory")
constexpr int NRB = 4;

__device__ __forceinline__ bf16x8 read_kfrag(LAS const char* Kb, int rowbase, int kk, int l15, int g) {
    return *(LAS const bf16x8*)(Kb + (rowbase + l15) * 128 + (((kk * 4 + g) ^ (l15 >> 1)) << 4));
}
__device__ __forceinline__ bf16x8 read_vfrag(LAS const char* Vb, int rowbase, int dt, int l15, int g) {
    const int p = l15 & 3;
    const int sw = ((2 * dt + (p >> 1)) ^ (((2 * g + (l15 >> 3)) & 3) << 1)) << 4;
    const int r0 = rowbase + 4 * g + (l15 >> 2);
    LAS const char* a0 = Vb + r0 * 128 + sw + (p & 1) * 8;
    const s16x4 lo = __builtin_bit_cast(s16x4, __builtin_amdgcn_ds_read_tr16_b64_v4i16((LAS s16x4*)a0));
    const s16x4 hi = __builtin_bit_cast(s16x4, __builtin_amdgcn_ds_read_tr16_b64_v4i16((LAS s16x4*)(a0 + 16 * 128)));
    return (bf16x8){lo[0], lo[1], lo[2], lo[3], hi[0], hi[1], hi[2], hi[3]};
}

template <bool NEAR, bool WMASK, bool LOFF>
__device__ __forceinline__ void attend32(LAS const char* Kb, LAS const char* Vb, int rowbase, const bf16x8 (&qf)[4][2], f32x4 (&o)[4][4],
                                         f32x4 (&l)[4], LAS const float* lutp, int dist0, float laneoff, const f32x4& lsplat, int l15, int g) {
    const bf16x8 ones = __builtin_bit_cast(bf16x8, (u32x4){0x3F803F80u, 0x3F803F80u, 0x3F803F80u, 0x3F803F80u});
    bf16x8 kf[2][2];
#pragma unroll
    for (int kt = 0; kt < 2; ++kt)
#pragma unroll
        for (int kk = 0; kk < 2; ++kk) kf[kt][kk] = read_kfrag(Kb, rowbase + 16 * kt, kk, l15, g);
    bf16x8 pf[4];
    bf16x8 vf[4];
#pragma unroll
    for (int dt = 0; dt < 4; ++dt) vf[dt] = read_vfrag(Vb, rowbase, dt, l15, g);
#pragma unroll
    for (int h = 0; h < 4; ++h) {
        f32x4 sh[2];
#pragma unroll
        for (int kt = 0; kt < 2; ++kt) {
            f32x4 ci;
            if (NEAR) { ci = (f32x4){lutp[h * LUTW + 16 * kt + 0], lutp[h * LUTW + 16 * kt + 1], lutp[h * LUTW + 16 * kt + 2], lutp[h * LUTW + 16 * kt + 3]};
                        if (LOFF) ci = ci + laneoff; }
            else { if (LOFF) ci = lsplat; else ci = (f32x4){0.f, 0.f, 0.f, 0.f}; }
            sh[kt] = mfma16(kf[kt][0], qf[h][0], ci);
            sh[kt] = mfma16(kf[kt][1], qf[h][1], sh[kt]);
        }
        float t[2][4];
#pragma unroll
        for (int kt = 0; kt < 2; ++kt)
#pragma unroll
            for (int r = 0; r < 4; ++r) {
                float tv = sh[kt][r];
                if (WMASK) { const int d = dist0 - 16 * kt - r; tv = (d >= 512) ? NEGBIG : tv; }
                t[kt][r] = fast_exp2(tv);
            }
        u32x4 pw; pw[0] = pack2(t[0][0], t[0][1]); pw[1] = pack2(t[0][2], t[0][3]); pw[2] = pack2(t[1][0], t[1][1]); pw[3] = pack2(t[1][2], t[1][3]);
        pf[h] = __builtin_bit_cast(bf16x8, pw);
        l[h] = mfma16(ones, pf[h], l[h]);
#pragma unroll
        for (int dt = 0; dt < 4; ++dt) o[h][dt] = mfma16(vf[dt], pf[h], o[h][dt]);
    }
}

__device__ __forceinline__ void load_qfrags(bf16x8 (&qf)[4][2], const bf16_t* qrow  , int g) {
#pragma unroll
    for (int h = 0; h < 4; ++h)
#pragma unroll
        for (int kk = 0; kk < 2; ++kk) qf[h][kk] = *(const bf16x8*)(qrow + h * 64 + kk * 32 + 8 * g);
#pragma unroll
    for (int h = 0; h < 4; ++h)
#pragma unroll
        for (int kk = 0; kk < 2; ++kk) asm volatile("" : "+v"(qf[h][kk]));
}

__device__ __forceinline__ void build_lut(int tid, LAS char* lds, const float* lutg, int kvh, int variant) {
    const float* src = lutg + (size_t)(variant * 4 + kvh) * (4 * LUTW) + tid;
    LAS float* dst = (LAS float*)(lds + LDS_LUT) + tid;
    dst[0] = src[0]; dst[512] = src[512];
    if (tid < 4 * LUTW - 1024) dst[1024] = src[1024];
}

struct RowT { u32x4 v[2]; };
__device__ __forceinline__ RowT rowt_load(const bf16_t* base  , size_t ld, int lane) {
    RowT r; const int rr = lane >> 3, cc = lane & 7;
    r.v[0] = *(const u32x4*)(base + (size_t)rr * ld + cc * 8); r.v[1] = *(const u32x4*)(base + (size_t)(rr + 8) * ld + cc * 8);
    return r;
}
__device__ __forceinline__ void rowt_store(bf16_t* base, size_t ld, int lane, const RowT& r) {
    const int rr = lane >> 3, cc = lane & 7;
    *(u32x4*)(base + (size_t)rr * ld + cc * 8) = r.v[0]; *(u32x4*)(base + (size_t)(rr + 8) * ld + cc * 8) = r.v[1];
}
__device__ __forceinline__ void rowt_to_lds(LAS char* stg, int lane, const RowT& r) {
    const int rr = lane >> 3, cc = lane & 7;
    *(LAS u32x4*)(stg + rr * 144 + cc * 16) = r.v[0]; *(LAS u32x4*)(stg + (rr + 8) * 144 + cc * 16) = r.v[1];
}
__device__ __forceinline__ RowT rowt_from_lds(LAS const char* stg, int lane) {
    RowT r; const int rr = lane >> 3, cc = lane & 7;
    r.v[0] = *(LAS const u32x4*)(stg + rr * 144 + cc * 16); r.v[1] = *(LAS const u32x4*)(stg + (rr + 8) * 144 + cc * 16);
    return r;
}
template <bool HASPREV>
__device__ __forceinline__ RowT gate_head(LAS char* stg, const f32x4 (&o)[4], float gs, const RowT& z, const RowT& prev, int lane, int l15, int g) {
#pragma unroll
    for (int dt = 0; dt < 4; ++dt) {
        u32x2 wv; wv[0] = pack2(o[dt][0] * gs, o[dt][1] * gs); wv[1] = pack2(o[dt][2] * gs, o[dt][3] * gs);
        *(LAS u32x2*)(stg + l15 * 144 + 32 * dt + 8 * g) = wv;
    }
    const RowT orow = rowt_from_lds(stg, lane);
    RowT r;
#pragma unroll
    for (int i = 0; i < 2; ++i)
#pragma unroll
        for (int e = 0; e < 4; ++e) {
            float lo = bflo(orow.v[i][e]) * bflo(z.v[i][e]), hi = bfhi(orow.v[i][e]) * bfhi(z.v[i][e]);
            if (HASPREV) { lo += bflo(prev.v[i][e]); hi += bfhi(prev.v[i][e]); }
            r.v[i][e] = pack2(lo, hi);
        }
    return r;
}
__device__ __forceinline__ void gate_branch4(LAS char* stg, bf16_t* ow  , size_t old_, const f32x4 (&o)[4][4], const f32x4 (&l)[4], const float* gbr  ,
                                             const bf16_t* zw  , int lane, int l15, int g) {
    RowT zq[4], pq[4]; float gv[4];
#pragma unroll
    for (int h = 0; h < 4; ++h) { gv[h] = gbr[h]; zq[h] = rowt_load(zw + h * 64, 3072, lane); pq[h] = rowt_load(ow + h * 64, old_, lane); }
#pragma unroll
    for (int h = 0; h < 4; ++h) {
        const float lt = l[h][0];
        const RowT r = gate_head<true>(stg, o[h], gv[h] / lt, zq[h], pq[h], lane, l15, g);
        rowt_store(ow + h * 64, old_, lane, r);
    }
}

__device__ __forceinline__ int attn_item(int rnd, int bid, int nblk) {
    if (rnd * nblk >= 1024) return -1;
    int it;
    if (nblk == 256) {
        const unsigned tab = (bid >> 6) == 0 ? 0x04CFu   : (bid >> 6) == 1 ? 0x13DEu   : (bid >> 6) == 2 ? 0x27ABu   : 0x5689u  ;
        const int Jt = (int)((tab >> (4 * rnd)) & 15u);
        it = (15 - Jt) * 64 + (bid & 63); }
    else it = rnd * nblk + ((rnd & 1) ? (nblk - 1 - bid) : bid);
    return it < 1024 ? it : -1;
}
__device__ __forceinline__ void attn_a_issue(int tid, LAS char* lds, const bf16_t* proj, int it) {
    const int J = 15 - (it >> 6), bh = it & 63, b = bh >> 2, kvh = bh & 3;
    const int jlo_a = 2 * J - 2 < 0 ? 0 : 2 * J - 2, nst = 2 * J + 2 - jlo_a;
    const bf16_t* kbase = proj + (size_t)b * S_ * A_IN + 1024 + kvh * 64;
#pragma unroll 1
    for (int t0 = 0; t0 < nst; ++t0) {
        dma_rows(tid, lds + LDS_TB + t0 * 16384, kbase + (size_t)(2 * J + 1 - t0) * 64 * A_IN, A_IN, 64, false);
        dma_rows(tid, lds + LDS_TB + t0 * 16384 + 8192, kbase + (size_t)(2 * J + 1 - t0) * 64 * A_IN + 256, A_IN, 64, true);
    }
}

__device__ __forceinline__ void phase_attn_a(const Params& p, LAS char* lds, int bid, int nblk, int layer) {
    const bf16_t* proj = (const bf16_t*)(p.ws + WS_Q);
    bf16_t* O = (bf16_t*)(p.ws + WS_KV);
    const float* lutg = (const float*)(p.ws + WS_LUT);
    LAS const float* lut = (LAS const float*)(lds + LDS_LUT);
    int lut_kvh = -1;
    {
        const int it0 = attn_item(0, bid, nblk);
        __syncthreads();
        if (it0 >= 0) attn_a_issue(opaque_tid(), lds, proj, it0);
    }
    for (int rnd = 0; rnd * nblk < 1024; ++rnd) {
        const int it = attn_item(rnd, bid, nblk);
        if (it < 0) continue;
        const int tid = opaque_tid();
        const int lane = tid & 63, w = tid >> 6, l15 = lane & 15, g = lane >> 4;
        const int J = 15 - (it >> 6), bh = it & 63, b = bh >> 2, kvh = bh & 3;
        const int jq = 2 * J + (w >> 2);
        const int qi = 16 * (w & 3) + l15;
        const size_t tg = (size_t)b * S_ + jq * 64 + qi;
        if (kvh != lut_kvh) { build_lut(tid, lds, lutg, kvh, 0); lut_kvh = kvh; }
        const int jlo_a = 2 * J - 2 < 0 ? 0 : 2 * J - 2;
        const int nst = 2 * J + 2 - jlo_a;
        bf16x8 qf[4][2];
        load_qfrags(qf, proj + tg * A_IN + kvh * 256, g);
        f32x4 o[4][4], l[4];
#pragma unroll
        for (int h = 0; h < 4; ++h) {
            l[h] = (f32x4){0.f, 0.f, 0.f, 0.f};
#pragma unroll
            for (int dt = 0; dt < 4; ++dt) o[h][dt] = (f32x4){0.f, 0.f, 0.f, 0.f};
        }
        DMA_WAIT(); __syncthreads();
        for (int st = 0; st < nst; ++st) {
            const int jk = 2 * J + 1 - st;
            const int dj = jq - jk;
            const int dist0 = dj * 64 + qi - 4 * g;
            LAS const float* lutp = lut + (255 - dist0);
            const f32x4 zsplat = (f32x4){0.f, 0.f, 0.f, 0.f};
            LAS const char* kb = lds + LDS_TB + st * 16384;
            if (dj >= 0 && dj <= 2) {
                const int sub_lo = (dj == 2 && (w & 3) >= 2) ? 1 : 0, sub_hi = (dj == 0 && (w & 3) < 2) ? 1 : 2;
#pragma unroll 1
                for (int sub = sub_lo; sub < sub_hi; ++sub)
                    attend32<true, false, false>(kb + sub * 4096, kb + 8192 + sub * 4096, 0, qf, o, l, lutp + 32 * sub, dist0 - 32 * sub, 0.f, zsplat, l15, g);
            }
        }
        __syncthreads();
        { const int itn = attn_item(rnd + 1, bid, nblk); if (itn >= 0) attn_a_issue(tid, lds, proj, itn); }
        {
            LAS char* stg = lds + LDS_GST + w * 2304;
            const bf16_t* zw = proj + (tg - l15) * A_IN + 1536 + kvh * 256;
            bf16_t* ow = O + (tg - l15) * D_ + kvh * 256;
            RowT zq[4];
#pragma unroll
            for (int h = 0; h < 4; ++h) zq[h] = rowt_load(zw + h * 64, A_IN, lane);
#pragma unroll
            for (int h = 0; h < 4; ++h) {
                const float lt = l[h][0] + fast_exp2(p.a_sink[layer * 16 + kvh * 4 + h] * LOG2E);
                const RowT r = gate_head<false>(stg, o[h], 1.0f / lt, zq[h], zq[h], lane, l15, g);
                rowt_store(ow + h * 64, D_, lane, r);
            }
        }
    }
}

__device__ __forceinline__ void attn_b_issue(int tid, LAS char* lds, const char* ws, int it) {
    const int J = 15 - (it >> 6), bh = it & 63, b = bh >> 2, kvh = bh & 3;
    dma_rows(tid, lds + LDS_K, (const bf16_t*)(ws + WS_KCMP) + (size_t)(b * 4 + kvh) * 128 * 64, 64, 128, false);
    dma_rows(tid, lds + LDS_V, (const bf16_t*)(ws + WS_VCMP) + (size_t)(b * 4 + kvh) * 128 * 64, 64, 128, true);
    const bf16_t* kvb = (const bf16_t*)(ws + WS_KV) + (size_t)b * S_ * KVW + kvh * 64;
#pragma unroll 1
    for (int t0 = 0; t0 < 2; ++t0) {
        const bf16_t* src = kvb + (size_t)(2 * J + 1 - t0) * 64 * KVW + 512;
        dma_rows(tid, lds + LDS_TB + t0 * 16384, src, KVW, 64, false);
        dma_rows(tid, lds + LDS_TB + t0 * 16384 + 8192, src + 256, KVW, 64, true);
    }
}

__device__ __forceinline__ void phase_attn_b(const Params& p, LAS char* lds, int bid, int nblk, bf16_t* obase, int old_, int pmode = 0) {
#define Q ((const bf16_t*)(p.ws + WS_Q))
#define Z ((const bf16_t*)(p.ws + WS_Z))
#define KV ((const bf16_t*)(p.ws + WS_KV))
#define KC ((const bf16_t*)(p.ws + WS_KCMP))
#define VC ((const bf16_t*)(p.ws + WS_VCMP))
#define GT ((const float*)(p.ws + WS_GATES))
#define lutg ((const float*)(p.ws + WS_LUT))
    LAS const float* lut = (LAS const float*)(lds + LDS_LUT);
    int lut_kvh = -1;
    {
        const int it0 = attn_item(0, bid, nblk);
        __syncthreads();
        if (it0 >= 0) attn_b_issue(opaque_tid(), lds, p.ws, it0);
    }
    for (int rnd = 0; rnd * nblk < 1024; ++rnd) {
        const int it = attn_item(rnd, bid, nblk);
        if (it < 0) continue;
        const int tid = opaque_tid();
        const int lane = tid & 63, w = tid >> 6, l15 = lane & 15, g = lane >> 4;
        const int J = 15 - (it >> 6), bh = it & 63, b = bh >> 2, kvh = bh & 3;
        const int jq = 2 * J + (w >> 2);
        const int qi = 16 * (w & 3) + l15;
        const int qpos = jq * 64 + qi;
        const size_t tg = (size_t)b * S_ + qpos;
        if (kvh != lut_kvh) { build_lut(tid, lds, lutg, kvh, 1); lut_kvh = kvh; }
        const bf16_t* kvb = KV + (size_t)b * S_ * KVW + kvh * 64;
        const int n_slc = 2 * J + 2;
        const int jlo_w = 2 * J - 8 < 0 ? 0 : 2 * J - 8;
        const int nst = n_slc + (2 * J + 2 - jlo_w);
#define TILE_SRC(s_) (kvb + (size_t)(2 * J + 1 - ((s_) >= n_slc ? (s_) - n_slc : (s_))) * 64 * KVW + ((s_) >= n_slc ? 1024 : 512))
        const int tgi = (int)tg;
#define TGO_() ({ int t_ = tgi; asm volatile("" : "+v"(t_)); (size_t)t_; })
#define zrow (Z + TGO_() * 3072 + kvh * 256)
#define grow (GT + TGO_() * 48 + kvh * 4)
#define orow (obase + TGO_() * old_ + kvh * 256)
#define qrow (Q + TGO_() * D_ + kvh * 256)
#define zwave (Z + (TGO_() - l15) * 3072 + kvh * 256)
#define owave (obase + (TGO_() - l15) * old_ + kvh * 256)
        LAS char* stg = lds + LDS_GST + w * 2304;
        bf16x8 qf[4][2];
        load_qfrags(qf, qrow, g);
        DMA_WAIT();
        __syncthreads();
        f32x4 psum[8];
#pragma unroll
        for (int kt = 0; kt < 8; ++kt) psum[kt] = (f32x4){0.f, 0.f, 0.f, 0.f};
        const bool rowvalid = qpos >= 31;
        const int nck = ((4 * jq + 2) >> 5) + 1;
#pragma unroll
        for (int h = 0; h < 4; ++h) {
            __builtin_amdgcn_sched_barrier(0);
            const bf16x8 q0 = qf[h][0], q1 = qf[h][1];
            LAS const float* luth = lut + h * LUTW;
            const RowT zq0 = rowt_load(zwave + h * 64, 3072, lane);
            const float gv0 = grow[h];
            f32x4 e[8];
            float ll = 0.f;
#pragma unroll
            for (int ck = 0; ck < 4; ++ck) {
                if (ck < nck) {
#pragma unroll
                    for (int kt = 0; kt < 2; ++kt) {
                        f32x4 sv = mfma16(read_kfrag(lds + LDS_K, 32 * ck + 16 * kt, 0, l15, g), q0, (f32x4){0.f, 0.f, 0.f, 0.f});
                        sv = mfma16(read_kfrag(lds + LDS_K, 32 * ck + 16 * kt, 1, l15, g), q1, sv);
                        const bool farg = (jq * 64 + 16 * (w & 3)) - 31 - 16 * (32 * ck + 16 * kt + 15) >= 128;
                        if (farg) {
#pragma unroll
                            for (int r = 0; r < 4; ++r) { const float ev = fast_exp2(sv[r]); e[2 * ck + kt][r] = ev; ll += ev; }
                        } else {
#pragma unroll
                        for (int r = 0; r < 4; ++r) {
                            int d = qpos - 31 - 16 * (32 * ck + 16 * kt + 4 * g + r);
                            d = d < -1 ? -1 : (d > 255 ? 255 : d);
                            const float ev = fast_exp2(sv[r] + luth[255 - d]);
                            e[2 * ck + kt][r] = ev; ll += ev;
                        }
                        }
                    }
                } else { e[2 * ck] = (f32x4){0.f, 0.f, 0.f, 0.f}; e[2 * ck + 1] = (f32x4){0.f, 0.f, 0.f, 0.f}; }
            }
            ll += __shfl_xor(ll, 16); ll += __shfl_xor(ll, 32);
            const float inv = rowvalid ? 1.0f / ll : 0.0f;
            f32x4 oc[4];
#pragma unroll
            for (int dt = 0; dt < 4; ++dt) oc[dt] = (f32x4){0.f, 0.f, 0.f, 0.f};
#pragma unroll
            for (int ck = 0; ck < 4; ++ck) {
                if (ck < nck) {
                    u32x4 pw; pw[0] = pack2(e[2 * ck][0], e[2 * ck][1]); pw[1] = pack2(e[2 * ck][2], e[2 * ck][3]);
                    pw[2] = pack2(e[2 * ck + 1][0], e[2 * ck + 1][1]); pw[3] = pack2(e[2 * ck + 1][2], e[2 * ck + 1][3]);
                    const bf16x8 pfr = __builtin_bit_cast(bf16x8, pw);
#pragma unroll
                    for (int dt = 0; dt < 4; ++dt) oc[dt] = mfma16(read_vfrag(lds + LDS_V, 32 * ck, dt, l15, g), pfr, oc[dt]);
                }
            }
#pragma unroll
            for (int kt = 0; kt < 8; ++kt) psum[kt] = psum[kt] + e[kt] * inv;
            { const RowT r = gate_head<false>(stg, oc, gv0 * inv, zq0, zq0, lane, l15, g); rowt_store(owave + h * 64, old_, lane, r); }
        }
        unsigned selbits;
        {
            float imp[8];
            const int src = (lane - 16) & 63;
#pragma unroll
            for (int kt = 0; kt < 8; ++kt) {
                const float own = (psum[kt][0] + psum[kt][1]) + (psum[kt][2] + psum[kt][3]);
                const float pa = __shfl(psum[kt][3], src);
                const float pb = (kt > 0) ? __shfl(psum[kt > 0 ? kt - 1 : 0][3], src) : 0.f;
                imp[kt] = own + (g > 0 ? pa : pb);
            }
            if (jq <= 7) {
                selbits = (2u << jq) - 1u;
            } else {
                selbits = 1u | (1u << jq) | (1u << (jq - 1));
                float cand[8];
#pragma unroll
                for (int kt = 0; kt < 8; ++kt) { const int j = 4 * kt + g; cand[kt] = (j >= 1 && j <= jq - 2) ? imp[kt] : -INFINITY; }
                for (int itn = 0; itn < 5; ++itn) {
                    float bv = -INFINITY; int bj = 99;
#pragma unroll
                    for (int kt = 0; kt < 8; ++kt) { if (cand[kt] > bv) { bv = cand[kt]; bj = 4 * kt + g; } }
#pragma unroll
                    for (int x = 16; x <= 32; x <<= 1) {
                        const float ov = __shfl_xor(bv, x); const int oj = __shfl_xor(bj, x);
                        if (ov > bv || (ov == bv && oj < bj)) { bv = ov; bj = oj; }
                    }
                    if (bj < 32) selbits |= 1u << bj;
#pragma unroll
                    for (int kt = 0; kt < 8; ++kt) { if (4 * kt + g == bj) cand[kt] = -INFINITY; }
                }
            }
        }
        f32x4 o[4][4], l[4];
#pragma unroll
        for (int h = 0; h < 4; ++h) { l[h] = (f32x4){0.f, 0.f, 0.f, 0.f};
#pragma unroll
            for (int dt = 0; dt < 4; ++dt) o[h][dt] = (f32x4){0.f, 0.f, 0.f, 0.f}; }
        for (int st = 0; st < nst; ++st) {
            const int br = st >= n_slc ? 1 : 0;
            const int jk = 2 * J + 1 - (br ? st - n_slc : st);
            const int dj = jq - jk;
            if ((st & 1) == 0) {
                if (st > 0) { DMA_WAIT(); asm volatile("s_waitcnt lgkmcnt(0)" ::: "memory"); __builtin_amdgcn_s_barrier(); asm volatile("" ::: "memory"); }
                if (st + 2 < nst) {
#pragma unroll 1
                    for (int t0 = st + 2; t0 < st + 4; ++t0) {
                        LAS char* nb = lds + LDS_TB + (t0 & 3) * 16384;
                        const bf16_t* kn = TILE_SRC(t0);
                        dma_rows(tid, nb, kn, KVW, 64, false);
                        dma_rows(tid, nb + 8192, kn + 256, KVW, 64, true);
                    }
                }
            }
            if (st == n_slc) {
                gate_branch4(stg, owave, old_, o, l, grow + 16, zwave + 1024, lane, l15, g);
#pragma unroll
                for (int h = 0; h < 4; ++h) {
                    l[h] = (f32x4){0.f, 0.f, 0.f, 0.f};
#pragma unroll
                    for (int dt = 0; dt < 4; ++dt) o[h][dt] = (f32x4){0.f, 0.f, 0.f, 0.f};
                }
            }
            const int dist0 = dj * 64 + qi - 4 * g;
            const float loff = (br == 0) ? (((selbits >> jk) & 1u) ? 0.f : NEGBIG) : 0.f;
            const f32x4 lsplat = (f32x4){loff, loff, loff, loff};
            LAS const float* lutp = lut + (255 - dist0);
            LAS const char* kb = lds + LDS_TB + (st & (NRB - 1)) * 16384;
            if (dj >= 0 && (br == 0 || dj <= 8) && pmode != 1) {
                const int sub_lo = (br == 1 && dj == 8 && (w & 3) >= 2) ? 1 : 0, sub_hi = (dj == 0 && (w & 3) < 2) ? 1 : (pmode == 2 ? 4 : 2);
                if (dj > 2 && !(br == 1 && dj == 8)) {
                    attend32<false, false, true>(kb, kb + 8192, 0, qf, o, l, lut, dist0, loff, lsplat, l15, g);
                    attend32<false, false, true>(kb + 4096, kb + 8192 + 4096, 0, qf, o, l, lut, dist0 - 32, loff, lsplat, l15, g);
                } else
#pragma unroll
                for (int sub = sub_lo; sub < sub_hi; ++sub) {
                    LAS const char* Kb = kb + (sub & 1) * 4096; LAS const char* Vb = kb + 8192 + (sub & 1) * 4096;
                    if (dj <= 2) attend32<true, false, true>(Kb, Vb, 0, qf, o, l, lutp + 32 * (sub & 1), dist0 - 32 * (sub & 1), loff, lsplat, l15, g);
                    else if (br == 1 && dj == 8) attend32<false, true, false>(Kb, Vb, 0, qf, o, l, lut, dist0 - 32 * (sub & 1), loff, lsplat, l15, g);
                    else attend32<false, false, true>(Kb, Vb, 0, qf, o, l, lut, dist0 - 32 * (sub & 1), loff, lsplat, l15, g);
                }
            }
        }
        asm volatile("s_waitcnt lgkmcnt(0)" ::: "memory"); __builtin_amdgcn_s_barrier(); asm volatile("" ::: "memory");
        { const int itn = attn_item(rnd + 1, bid, nblk); if (itn >= 0) attn_b_issue(tid, lds, p.ws, itn); }
        gate_branch4(stg, owave, old_, o, l, grow + 32, zwave + 2048, lane, l15, g);
    }
}

#undef TGO_
#undef zwave
#undef owave
#undef TILE_SRC
#undef zrow
#undef grow
#undef orow
#undef qrow
#undef Q
#undef Z
#undef KV
#undef KC
#undef VC
#undef GT
#undef lutg

#define XB_TMO      128
#define XB_XCNT(j)  (256  + 64 * (j))
#define XB_XSUB(j)  (1280 + 64 * (j))
#define XB_XGEN(j)  (2304 + 64 * (j))
#define XB_TOP      3328
#define XB_TOPGEN   3392
#define XCD_BAR_WORDS 3456
#define XB_SPIN_CAP (1u << 18)
__device__ __forceinline__ unsigned xb_ld(unsigned* p)              { return __hip_atomic_load(p, __ATOMIC_RELAXED, __HIP_MEMORY_SCOPE_AGENT); }
__device__ __forceinline__ unsigned xb_add(unsigned* p, unsigned v) { return __hip_atomic_fetch_add(p, v, __ATOMIC_RELAXED, __HIP_MEMORY_SCOPE_AGENT); }
__device__ __forceinline__ unsigned xb_xcc_id() { return (unsigned)__builtin_amdgcn_s_getreg((3 << 11) | 20) & 0xFu; }
#define XB_SPIN(cond, bar) do { unsigned _sp = 0; while (cond) { __builtin_amdgcn_s_sleep(1); \
    if ((++_sp & 255u) == 0u) { if (xb_ld(&(bar)[XB_TMO])) break; if (_sp > XB_SPIN_CAP) { atomicAdd(&(bar)[XB_TMO], 1u); break; } } } } while (0)
struct XcdBarrier { unsigned* bar; unsigned x; volatile LAS unsigned* st; };
__device__ __forceinline__ XcdBarrier xcd_barrier_post(unsigned* bar, volatile LAS unsigned* st) {
    XcdBarrier b; b.bar = bar; b.x = xb_xcc_id(); b.st = st;
    if (threadIdx.x == 0) (void)xb_add(&bar[XB_XCNT(b.x)], 1u);
    return b;
}
__device__ __forceinline__ void xcd_barrier_complete(unsigned* bar, unsigned x, unsigned& nloc, unsigned& nx) {
    const unsigned G = gridDim.x * gridDim.y * gridDim.z;
    unsigned sum, cnt, mine, sp = 0u;
    for (;;) {
        sum = 0u; cnt = 0u; mine = 0u;
#pragma unroll
        for (unsigned j = 0; j < 16; ++j) { const unsigned c = xb_ld(&bar[XB_XCNT(j)]); sum += c; cnt += (c > 0u) ? 1u : 0u; mine = (j == x) ? c : mine; }
        if (sum == G) break;
        __builtin_amdgcn_s_sleep(1);
        if ((++sp & 255u) == 0u) { if (xb_ld(&bar[XB_TMO])) break; if (sp > XB_SPIN_CAP) { atomicAdd(&bar[XB_TMO], 1u); break; } }
    }
    nloc = mine > 0u ? mine : 1u; nx = cnt > 0u ? cnt : 1u;
}
__device__ __forceinline__ void xcd_barrier(const XcdBarrier& b) {
    asm volatile("s_waitcnt vmcnt(0)" ::: "memory");
    __syncthreads();
    if (threadIdx.x == 0) {
        unsigned* bar = b.bar;
        __builtin_amdgcn_s_waitcnt(0);
        unsigned nloc = b.st[0], nx = b.st[1];
        if (nloc == 0u) { xcd_barrier_complete(bar, b.x, nloc, nx); b.st[0] = nloc; b.st[1] = nx; }
        const unsigned old = xb_add(&bar[XB_XSUB(b.x)], 1u);
        const unsigned gen = old / nloc;
        if (old + 1u == (gen + 1u) * nloc) {
            __builtin_amdgcn_fence(__ATOMIC_RELEASE, "agent");
            asm volatile("s_waitcnt vmcnt(0)" ::: "memory");
            const unsigned og = xb_add(&bar[XB_TOP], 1u);
            const unsigned tg = og / nx;
            if (og + 1u == (tg + 1u) * nx) xb_add(&bar[XB_TOPGEN], 1u);
            else XB_SPIN(xb_ld(&bar[XB_TOPGEN]) == tg, bar);
            __builtin_amdgcn_fence(__ATOMIC_ACQUIRE, "agent");
            xb_add(&bar[XB_XGEN(b.x)], 1u);
            asm volatile("s_waitcnt vmcnt(0)" ::: "memory");
        } else {
            XB_SPIN(xb_ld(&bar[XB_XGEN(b.x)]) == gen, bar);
            __builtin_amdgcn_fence(__ATOMIC_ACQUIRE, "agent");
            asm volatile("s_waitcnt vmcnt(0)" ::: "memory");
        }
    }
    __syncthreads();
}

constexpr int LDS_XB = pg8::STAGE_BYTES;
constexpr int LDS_BYTES = pg8::GAIN_OFF + 1024;
constexpr int NPHASE = 15;

template <bool F16, class Epi, class AFn>
__device__ __forceinline__ void run_gemm(LAS char* lds, const bf16_t* A, const bf16_t* Bt, int M, int N, int K, int G, int c, const Epi& E, const AFn& AF) {
    pg8::Gemm g{A, Bt, M, N, K};
    pg8::StaticOrder S; S.init(M, N, G, c);
    pg8::gemm_phase<Epi, pg8::StaticOrder, AFn, true, true, F16>((PG8_LAS unsigned char*)lds, g, S, E, AF);
}

template <int ph> __device__ __forceinline__ void run_phase(const Params& p, LAS char* lds, int bid, int nblk) {
    char* ws = p.ws;
    const float* part = (const float*)(ws + WS_PART);
    if (ph == 0) { phase_prep(p, lds, bid, nblk); return; }
    if (ph == 1 || ph == 4) {
        const int L = (ph == 1) ? 0 : 1;
        EpiProj<GfA> epi{part, GfA{(bf16_t*)(ws + WS_Q), p.a_q_gain + L * 64, p.a_k_gain + L * 64}};
        run_gemm<true>(lds, (const bf16_t*)(ws + WS_XB), (const bf16_t*)(ws + WS_WINA) + (size_t)L * A_IN * D_, T_, A_IN, D_, nblk, bid, epi, pg8::ALinear{D_});
        return;
    }
    if (ph == 2 || ph == 5) { phase_attn_a(p, lds, bid, nblk, ph == 2 ? 0 : 1); return; }
    if (ph == 3 || ph == 6 || ph == 11 || ph == 14) {
        const bf16_t* A; int lda = D_; const bf16_t* Wt;
        if (ph == 3) { A = (const bf16_t*)(ws + WS_KV); Wt = (const bf16_t*)(ws + WS_WOUTA); }
        else if (ph == 6) { A = (const bf16_t*)(ws + WS_KV); Wt = (const bf16_t*)(ws + WS_WOUTA) + (size_t)D_ * D_; }
        else if (ph == 11) { A = (const bf16_t*)(ws + WS_Z); Wt = (const bf16_t*)(ws + WS_WOUTB); lda = 3072; }
        else { A = (const bf16_t*)(ws + WS_Z); Wt = (const bf16_t*)(ws + WS_WOUTB) + (size_t)D_ * D_; lda = 3072; }
        if (ph == 14) { EpiOut<true> epi{(bf16_t*)(ws + WS_XB), p.out, (float*)(ws + WS_PART)}; run_gemm<false>(lds, A, Wt, T_, D_, D_, nblk, bid, epi, pg8::ALinear{lda}); }
        else { EpiOut<false> epi{(bf16_t*)(ws + WS_XB), p.out, (float*)(ws + WS_PART)}; run_gemm<false>(lds, A, Wt, T_, D_, D_, nblk, bid, epi, pg8::ALinear{lda}); }
        return;
    }
    if (ph == 7 || ph == 12) {
        const int kvg = (ph == 7) ? 24 : 0;
        const int L = (ph == 7) ? 0 : 1;
        EpiProj<GfB> epi{part, GfB{kvg, (bf16_t*)(ws + WS_KV), p.kv_k_gain, (bf16_t*)(ws + WS_Q), (bf16_t*)(ws + WS_Z), (float*)(ws + WS_GATES), p.b_q_gain + L * 64}};
        run_gemm<true>(lds, (const bf16_t*)(ws + WS_XB), (const bf16_t*)(ws + (ph == 7 ? WS_WKVB0 : WS_WINB1)), T_, ph == 7 ? KVB_N : B_INP, D_, nblk, bid, epi, pg8::ALinear{D_});
        return;
    }
    if (ph == 8) {
        if (bid >= 64 && nblk > 64) {
            EpiProj<GfG> epg{part, GfG{(float*)(ws + WS_GATES)}};
            run_gemm<true>(lds, (const bf16_t*)(ws + WS_XB), (const bf16_t*)(ws + WS_WG0), T_, 256, D_, nblk - 64, bid - 64, epg, pg8::ALinear{D_});
            return;
        }
        const int which = bid & 1;
        EpiProj<GfC1> epi{nullptr, GfC1{(bf16_t*)(ws + WS_HID) + (size_t)which * 8192 * 256, (const float*)(ws + WS_CB) + which * 256}};
        run_gemm<false>(lds, (const bf16_t*)(ws + WS_KV), (const bf16_t*)(ws + WS_W1) + (size_t)which * 256 * 2048, 8192, 256, 2048, nblk >> 1, bid >> 1, epi, pg8::ACmp{which * 256});
        return;
    }
    if (ph == 9) {
        { EpiProj<GfC2<1>> epi{nullptr, GfC2<1>{(bf16_t*)(ws + WS_KCMP), p.kv_k_gain}};
          run_gemm<false>(lds, (const bf16_t*)(ws + WS_HID), (const bf16_t*)(ws + WS_W2), 8192, 256, 256, nblk, bid, epi, pg8::ALinear{256}); }
        { EpiProj<GfC2<0>> epi{nullptr, GfC2<0>{(bf16_t*)(ws + WS_VCMP), p.kv_k_gain}};
          run_gemm<false>(lds, (const bf16_t*)(ws + WS_HID) + (size_t)8192 * 256, (const bf16_t*)(ws + WS_W2) + (size_t)256 * 256, 8192, 256, 256, nblk, (bid + 128) % nblk, epi, pg8::ALinear{256}); }
        return;
    }
    if (ph == 10 || ph == 13) { phase_attn_b(p, lds, bid, nblk, (bf16_t*)(ws + WS_Z), 3072); return; }
    if (ph == 100) { phase_attn_b(p, lds, bid, nblk, (bf16_t*)p.out, 1024, p.njobs > 0 ? PROBE_MODE : 0); return; }
}

__global__ void __launch_bounds__(NTHR, 2) mega_kernel(Params p) {
    extern __shared__ __attribute__((aligned(16))) unsigned char lds_dyn[];
    LAS char* lds = (LAS char*)lds_dyn;
    cg::grid_group grid = cg::this_grid();
    if (p.njobs < 0) grid.sync();
    volatile LAS unsigned* xst = (volatile LAS unsigned*)(lds + LDS_XB);
    if (threadIdx.x < 4) xst[threadIdx.x] = 0u;
    __syncthreads();
    (void)xcd_barrier_post((unsigned*)p.ws, xst);
#define PH_(n) run_phase<n>(p, lds, blockIdx.x, gridDim.x)
#define SYNC_() do { XcdBarrier xb_; xb_.bar = (unsigned*)p.ws; xb_.x = xb_xcc_id(); xb_.st = (volatile LAS unsigned*)(lds + LDS_XB); xcd_barrier(xb_); } while (0)
#ifdef DUP_PH
#define DUP_(n) if (DUP_PH == n) { PH_(n); SYNC_(); }
#else
#define DUP_(n)
#endif
    PH_(0); SYNC_(); DUP_(0) PH_(1); SYNC_(); DUP_(1) PH_(2); SYNC_(); DUP_(2) PH_(3); SYNC_(); DUP_(3) PH_(4); SYNC_(); PH_(5); SYNC_(); PH_(6); SYNC_();
    PH_(7); SYNC_(); DUP_(7) PH_(8); SYNC_(); DUP_(8) PH_(9); SYNC_(); DUP_(9) DUP_(100) PH_(10); SYNC_(); PH_(11); SYNC_(); PH_(12); SYNC_(); DUP_(12) PH_(13); SYNC_(); PH_(14);
#undef PH_
#undef SYNC_
}

static void add_job(Params& p, const float* src, bf16_t* dst, const float* gain, int ldsrc, int K, int nsrc0, int ndst0, int ncols, int f16 = 0) {
    ConvJob& j = p.jobs[p.njobs++];
    j.f16 = f16; j.pad = 0;
    j.src = src; j.dst = dst; j.gain = gain; j.ldsrc = ldsrc; j.K = K; j.nsrc0 = nsrc0; j.ndst0 = ndst0; j.ncols = ncols; j.tile0 = p.nconv_tiles;
    p.nconv_tiles += (K / 64) * ((ncols + 63) / 64);
}

extern "C" void kernel_launch(void* const* d_in, const int* in_sizes, int n_in, void* d_out, int out_size, void* d_ws, size_t ws_size, hipStream_t stream) {
    Params p;
    memset(&p, 0, sizeof(p));
    const float** f = (const float**)d_in;
    p.x = f[0]; p.rel_table = f[1]; p.a_norm = f[2]; p.a_w_in = f[3]; p.a_q_gain = f[4]; p.a_k_gain = f[5]; p.a_sink = f[6]; p.a_w_out = f[7];
    p.kv_norm = f[8]; p.kv_w = f[9]; p.kv_k_gain = f[10]; p.cmp_k_pos = f[11]; p.cmp_k_w1 = f[12]; p.cmp_k_w2 = f[13];
    p.cmp_v_pos = f[14]; p.cmp_v_w1 = f[15]; p.cmp_v_w2 = f[16]; p.b_norm = f[17]; p.b_w_in = f[18]; p.b_q_gain = f[19]; p.b_w_out = f[20];
    p.out = (float*)d_out; p.ws = (char*)d_ws;
    char* ws = (char*)d_ws;
    for (int L = 0; L < 2; ++L) {
        add_job(p, p.a_w_in + (size_t)L * D_ * A_IN, (bf16_t*)(ws + WS_WINA) + (size_t)L * A_IN * D_, p.a_norm + L * D_, A_IN, D_, 0, 0, A_IN, 1);
        add_job(p, p.a_w_out + (size_t)L * D_ * D_, (bf16_t*)(ws + WS_WOUTA) + (size_t)L * D_ * D_, nullptr, D_, D_, 0, 0, D_);
        add_job(p, p.b_w_out + (size_t)L * D_ * D_, (bf16_t*)(ws + WS_WOUTB) + (size_t)L * D_ * D_, nullptr, D_, D_, 0, 0, D_);
    }
    add_job(p, p.kv_w, (bf16_t*)(ws + WS_WKVB0), p.kv_norm, KVW, D_, 0, 0, KVW, 1);
    for (int L = 0; L < 2; ++L) {
        bf16_t* dst = (L == 0) ? (bf16_t*)(ws + WS_WKVB0) + (size_t)KVW * D_ : (bf16_t*)(ws + WS_WINB1);
        const float* src = p.b_w_in + (size_t)L * D_ * 4144;
        const float* gn = p.b_norm + L * D_;
        add_job(p, src, dst, gn, 4144, D_, 0, 0, 1024, 1);
        add_job(p, src, dst, gn, 4144, D_, 1072, 1024, 3072, 1);
        bf16_t* gdst = (L == 0) ? (bf16_t*)(ws + WS_WG0) : dst;
        const int g0 = (L == 0) ? 0 : 4096;
        add_job(p, src, gdst, gn, 4144, D_, 1024, g0, 48, 1);
        add_job(p, nullptr, gdst, nullptr, 4144, D_, 0, g0 + 64, 192);
    }
    add_job(p, p.cmp_k_w1, (bf16_t*)(ws + WS_W1), nullptr, 256, 2048, 0, 0, 256);
    add_job(p, p.cmp_v_w1, (bf16_t*)(ws + WS_W1) + (size_t)256 * 2048, nullptr, 256, 2048, 0, 0, 256);
    add_job(p, p.cmp_k_w2, (bf16_t*)(ws + WS_W2), nullptr, 64, 256, 0, 0, 64);
    add_job(p, nullptr, (bf16_t*)(ws + WS_W2), nullptr, 64, 256, 0, 64, 192);
    add_job(p, p.cmp_v_w2, (bf16_t*)(ws + WS_W2) + (size_t)256 * 256, nullptr, 64, 256, 0, 0, 64);
    add_job(p, nullptr, (bf16_t*)(ws + WS_W2) + (size_t)256 * 256, nullptr, 64, 256, 0, 64, 192);
    static int grid_blocks = 0;
    if (!grid_blocks) {
        int dev = 0, cus = 0, per_cu = 0;
        (void)hipGetDevice(&dev);
        (void)hipDeviceGetAttribute(&cus, hipDeviceAttributeMultiprocessorCount, dev);
        (void)hipFuncSetAttribute((const void*)mega_kernel, hipFuncAttributeMaxDynamicSharedMemorySize, LDS_BYTES);
        (void)hipOccupancyMaxActiveBlocksPerMultiprocessor(&per_cu, mega_kernel, NTHR, LDS_BYTES);
        (void)hipGetLastError();
        grid_blocks = cus;
        if (per_cu < 1) fprintf(stderr, "note: occupancy query reports %d workgroups per CU\n", per_cu);
    }
    void* args[] = {&p};
    (void)hipMemsetAsync(d_ws, 0, 16384, stream);
    hipError_t e = hipLaunchCooperativeKernel((void*)mega_kernel, dim3(grid_blocks), dim3(NTHR), args, LDS_BYTES, stream);
    if (e != hipSuccess) fprintf(stderr, "cooperative launch failed: %s (grid %d)\n", hipGetErrorString(e), grid_blocks);
}
```
